# Optimizing an MI355X kernel written in HIP

```python
import math
import jax, jax.numpy as jnp
from jax import lax
import numpy as np

D_MODEL = 2048
BATCH = 4
SEQ = 2048
DEPTH = 4

MLA_HEADS = 8
MLA_NOPE = 128
MLA_ROPE = 64
MLA_V = 128
MLA_Q_LORA = 512
MLA_KV_LORA = 256
MLA_WIDTH = MLA_HEADS * MLA_V
ROPE_THETA = 10000.0

SSM_WIDTH = D_MODEL // 4
SSM_GROUP = 16
SSM_GROUPS = SSM_WIDTH // SSM_GROUP
SSM_STATE = 64

DIL_WIDTH = D_MODEL // 4
DIL_HEAD_DIM = 64
DIL_HEADS = DIL_WIDTH // DIL_HEAD_DIM
DIL_PATTERNS = ((128, 1), (512, 4), (2048, 16))

BLOCK = 128
MIX_WIDTH = MLA_WIDTH + SSM_WIDTH + DIL_WIDTH
IN_SPLITS = (MLA_Q_LORA, MLA_KV_LORA, MLA_ROPE, SSM_WIDTH, DIL_WIDTH, DIL_WIDTH, DIL_WIDTH)
IN_WIDTH = sum(IN_SPLITS)
D_FF = ((8 * D_MODEL + 3 * 256 - 1) // (3 * 256)) * 256
NORM_EPS = 1e-6

kernel_name = "hymba_mla_s5_dilated_hybrid"


def rms_norm(x, g):
    xf = x.astype(jnp.float32)
    y = xf * lax.rsqrt(jnp.mean(xf * xf, axis=-1, keepdims=True) + NORM_EPS)
    return (y * g.astype(jnp.float32)).astype(x.dtype)


def apply_rope(x, pos):
    half = x.shape[-1] // 2
    inv_freq = ROPE_THETA ** (-jnp.arange(half, dtype=jnp.float32) / half)
    ang = pos.astype(jnp.float32)[:, None] * inv_freq[None, :]
    cos = jnp.cos(ang)[None, :, None, :]
    sin = jnp.sin(ang)[None, :, None, :]
    xf = x.astype(jnp.float32)
    x1, x2 = xf[..., :half], xf[..., half:]
    return jnp.concatenate([x1 * cos - x2 * sin, x2 * cos + x1 * sin], axis=-1).astype(x.dtype)


def mla_mixer(c_q, c_kv, k_rope, g_q, w_uq, g_kv, w_ukv):
    B, S, _ = c_q.shape
    pos = jnp.arange(S)
    q = (rms_norm(c_q, g_q) @ w_uq).reshape(B, S, MLA_HEADS, MLA_NOPE + MLA_ROPE)
    q_nope = q[..., :MLA_NOPE]
    q_pe = apply_rope(q[..., MLA_NOPE:], pos)
    kv = (rms_norm(c_kv, g_kv) @ w_ukv).reshape(B, S, MLA_HEADS, MLA_NOPE + MLA_V)
    k_nope, v = kv[..., :MLA_NOPE], kv[..., MLA_NOPE:]
    k_pe = apply_rope(k_rope[:, :, None, :], pos)[:, :, 0]
    scale = (MLA_NOPE + MLA_ROPE) ** -0.5
    nb = S // BLOCK
    qn_b = q_nope.reshape(B, nb, BLOCK, MLA_HEADS, MLA_NOPE).transpose(1, 0, 2, 3, 4)
    qp_b = q_pe.reshape(B, nb, BLOCK, MLA_HEADS, MLA_ROPE).transpose(1, 0, 2, 3, 4)
    kpos = jnp.arange(S)

    def one_block(args):
        b, qn, qp = args
        s = (jnp.einsum('bqhd,bkhd->bhqk', qn, k_nope).astype(jnp.float32)
             + jnp.einsum('bqhd,bkd->bhqk', qp, k_pe).astype(jnp.float32)) * scale
        qpos = b * BLOCK + jnp.arange(BLOCK)
        causal = qpos[:, None] >= kpos[None, :]
        s = jnp.where(causal[None, None], s, -jnp.inf)
        p = jax.nn.softmax(s, axis=-1).astype(v.dtype)
        return jnp.einsum('bhqk,bkhd->bqhd', p, v)

    out = lax.map(one_block, (jnp.arange(nb), qn_b, qp_b))
    return out.transpose(1, 0, 2, 3, 4).reshape(B, S, MLA_WIDTH)


def s5_mixer(u, a_re, a_im, b_re, b_im, c_re, c_im, d_skip, log_dt, w_glu, b_glu):
    B, S, _ = u.shape
    f32 = jnp.float32
    uf = u.astype(f32).reshape(B, S, SSM_GROUPS, SSM_GROUP)
    lam = lax.complex(jnp.minimum(a_re.astype(f32), -1e-4), a_im.astype(f32))
    dt = jnp.exp(log_dt.astype(f32))[:, None]
    a_bar = jnp.exp(lam * dt)
    b_cplx = lax.complex(b_re.astype(f32), b_im.astype(f32))
    b_bar = ((a_bar - 1.0) / lam)[..., None] * b_cplx
    bu = jnp.einsum('gnp,bsgp->bsgn', b_bar, uf.astype(jnp.complex64))
    a_seq = jnp.broadcast_to(a_bar, bu.shape)

    def combine(left, right):
        a_l, h_l = left
        a_r, h_r = right
        return a_r * a_l, a_r * h_l + h_r

    _, h = lax.associative_scan(combine, (a_seq, bu), axis=1)
    c_cplx = lax.complex(c_re.astype(f32), c_im.astype(f32))
    y = jnp.einsum('gpn,bsgn->bsgp', c_cplx, h).real + d_skip.astype(f32) * uf
    y = jax.nn.gelu(y.reshape(B, S, SSM_WIDTH))
    z = y @ w_glu.astype(f32) + b_glu.astype(f32)
    out = z[..., :SSM_WIDTH] * jax.nn.sigmoid(z[..., SSM_WIDTH:])
    return out.astype(u.dtype)


def strided_fold(x, dil):
    B, S = x.shape[:2]
    rest = x.shape[2:]
    return x.reshape(B, S // dil, dil, *rest).swapaxes(1, 2).reshape(B * dil, S // dil, *rest)


def strided_unfold(x, batch, dil):
    L = x.shape[1]
    rest = x.shape[2:]
    return x.reshape(batch, dil, L, *rest).swapaxes(1, 2).reshape(batch, L * dil, *rest)


def banded_window_attention(q, k, v, span):
    Z, L, H, D = q.shape
    nb = -(-L // BLOCK)
    Lp = nb * BLOCK
    pad = ((0, 0), (0, Lp - L), (0, 0), (0, 0))
    qb, kb, vb = [jnp.pad(t, pad).reshape(Z, nb, BLOCK, H, D) for t in (q, k, v)]

    def with_prev(t):
        prev = jnp.pad(t, ((0, 0), (1, 0), (0, 0), (0, 0), (0, 0)))[:, :-1]
        return jnp.concatenate([prev, t], axis=2)

    kk, vv = with_prev(kb), with_prev(vb)
    s = jnp.einsum('znqhd,znkhd->znhqk', qb, kk).astype(jnp.float32) * (D ** -0.5)
    qpos = jnp.arange(nb)[:, None] * BLOCK + jnp.arange(BLOCK)[None, :]
    kpos = (jnp.arange(nb)[:, None] - 1) * BLOCK + jnp.arange(2 * BLOCK)[None, :]
    dist = qpos[:, :, None] - kpos[:, None, :]
    mask = (dist >= 0) & (dist <= span) & (kpos[:, None, :] >= 0)
    s = jnp.where(mask[None, :, None], s, -jnp.inf)
    m = jnp.max(s, axis=-1, keepdims=True)
    p = jnp.exp(s - m)
    l = jnp.sum(p, axis=-1, keepdims=True)
    o = jnp.einsum('znhqk,znkhd->znqhd', (p / l).astype(v.dtype), vv)
    lse = (m + jnp.log(l))[..., 0].transpose(0, 1, 3, 2).reshape(Z, Lp, H)
    return o.reshape(Z, Lp, H, D)[:, :L], lse[:, :L]


def dilated_mixer(qd, kd, vd):
    B, S, _ = qd.shape
    q, k, v = [t.reshape(B, S, DIL_HEADS, DIL_HEAD_DIM) for t in (qd, kd, vd)]
    outs, lses = [], []
    for window, dil in DIL_PATTERNS:
        o, lse = banded_window_attention(strided_fold(q, dil), strided_fold(k, dil),
                                         strided_fold(v, dil), window // dil)
        outs.append(strided_unfold(o, B, dil).astype(jnp.float32))
        lses.append(strided_unfold(lse, B, dil))
    wts = jax.nn.softmax(jnp.stack(lses, axis=0), axis=0)
    out = wts[0][..., None] * outs[0] + wts[1][..., None] * outs[1] + wts[2][..., None] * outs[2]
    return out.reshape(B, S, DIL_WIDTH).astype(qd.dtype)


def setup_inputs(seed: int = 0) -> dict:
    key = jax.random.key(seed)
    ks = jax.random.split(key, 32)
    L = DEPTH
    nrm = lambda k, shape, scale: jax.random.normal(k, shape, jnp.float32) * scale
    gain = lambda k, n: 1.0 + 0.02 * jax.random.normal(k, (L, n), jnp.float32)
    out_scale = (2 * DEPTH) ** -0.5
    n_idx = jnp.arange(SSM_STATE, dtype=jnp.float32)
    return {
        "x": jax.random.normal(ks[0], (BATCH, SEQ, D_MODEL), jnp.float32),
        "g_mix": gain(ks[1], D_MODEL),
        "w_in": nrm(ks[2], (L, D_MODEL, IN_WIDTH), D_MODEL ** -0.5),
        "g_q": gain(ks[3], MLA_Q_LORA),
        "w_uq": nrm(ks[4], (L, MLA_Q_LORA, MLA_HEADS * (MLA_NOPE + MLA_ROPE)), MLA_Q_LORA ** -0.5),
        "g_kv": gain(ks[5], MLA_KV_LORA),
        "w_ukv": nrm(ks[6], (L, MLA_KV_LORA, MLA_HEADS * (MLA_NOPE + MLA_V)), MLA_KV_LORA ** -0.5),
        "a_re": -0.5 + nrm(ks[7], (L, SSM_GROUPS, SSM_STATE), 0.01),
        "a_im": math.pi * n_idx + nrm(ks[8], (L, SSM_GROUPS, SSM_STATE), 0.01),
        "b_re": nrm(ks[9], (L, SSM_GROUPS, SSM_STATE, SSM_GROUP), (2 * SSM_GROUP) ** -0.5),
        "b_im": nrm(ks[10], (L, SSM_GROUPS, SSM_STATE, SSM_GROUP), (2 * SSM_GROUP) ** -0.5),
        "c_re": nrm(ks[11], (L, SSM_GROUPS, SSM_GROUP, SSM_STATE), 0.5),
        "c_im": nrm(ks[12], (L, SSM_GROUPS, SSM_GROUP, SSM_STATE), 0.5),
        "d_skip": nrm(ks[13], (L, SSM_GROUPS, SSM_GROUP), 1.0),
        "log_dt": jax.random.uniform(ks[14], (L, SSM_GROUPS), jnp.float32,
                                     math.log(1e-3), math.log(1e-1)),
        "w_glu": nrm(ks[15], (L, SSM_WIDTH, 2 * SSM_WIDTH), SSM_WIDTH ** -0.5),
        "b_glu": nrm(ks[16], (L, 2 * SSM_WIDTH), 0.01),
        "g_out_mla": gain(ks[17], MLA_WIDTH),
        "g_out_ssm": gain(ks[18], SSM_WIDTH),
        "g_out_dil": gain(ks[19], DIL_WIDTH),
        "w_o": nrm(ks[20], (L, MIX_WIDTH, D_MODEL), MIX_WIDTH ** -0.5 * out_scale),
        "g_ffn": gain(ks[21], D_MODEL),
        "w_gate": nrm(ks[22], (L, D_MODEL, D_FF), D_MODEL ** -0.5),
        "w_up": nrm(ks[23], (L, D_MODEL, D_FF), D_MODEL ** -0.5),
        "w_down": nrm(ks[24], (L, D_FF, D_MODEL), D_FF ** -0.5 * out_scale),
        "g_final": 1.0 + 0.02 * jax.random.normal(ks[25], (D_MODEL,), jnp.float32),
    }


def reference(x, g_mix, w_in, g_q, w_uq, g_kv, w_ukv, a_re, a_im, b_re, b_im, c_re, c_im,
              d_skip, log_dt, w_glu, b_glu, g_out_mla, g_out_ssm, g_out_dil, w_o,
              g_ffn, w_gate, w_up, w_down, g_final):
    split_at = np.cumsum(IN_SPLITS)[:-1].tolist()
    for l in range(DEPTH):
        h = rms_norm(x, g_mix[l])
        proj = h @ w_in[l]
        c_q, c_kv, k_rope, u, qd, kd, vd = jnp.split(proj, split_at, axis=-1)
        y_mla = mla_mixer(c_q, c_kv, k_rope, g_q[l], w_uq[l], g_kv[l], w_ukv[l])
        y_ssm = s5_mixer(u, a_re[l], a_im[l], b_re[l], b_im[l], c_re[l], c_im[l],
                         d_skip[l], log_dt[l], w_glu[l], b_glu[l])
        y_dil = dilated_mixer(qd, kd, vd)
        y = jnp.concatenate([rms_norm(y_mla, g_out_mla[l]),
                             rms_norm(y_ssm, g_out_ssm[l]),
                             rms_norm(y_dil, g_out_dil[l])], axis=-1)
        x = x + y @ w_o[l]
        h = rms_norm(x, g_ffn[l])
        x = x + (jax.nn.silu(h @ w_gate[l]) * (h @ w_up[l])) @ w_down[l]
    return rms_norm(x, g_final)
```

```cpp
#include <hip/hip_runtime.h>
#include <hip/hip_cooperative_groups.h>
#include <cstdio>
#include <cstdint>
namespace cg = cooperative_groups;
#ifndef DUP_MIX
#define DUP_MIX 0
#endif
#ifndef DUP_GEMM
#define DUP_GEMM 0
#endif
#ifndef GEMM_MASK
#define GEMM_MASK 127
#endif

#define LAS __attribute__((address_space(3)))
typedef unsigned short bf16_t;
typedef short bf16x8 __attribute__((ext_vector_type(8)));
typedef short s16x4 __attribute__((ext_vector_type(4)));
typedef float f32x4 __attribute__((ext_vector_type(4)));
typedef float f32x2 __attribute__((ext_vector_type(2)));
typedef float f32x16 __attribute__((ext_vector_type(16)));
typedef unsigned u32x4 __attribute__((ext_vector_type(4)));
typedef unsigned u32x2 __attribute__((ext_vector_type(2)));
typedef __bf16 bf16x2_t __attribute__((ext_vector_type(2)));
#define DI __device__ __forceinline__

constexpr int M_ = 8192, D_ = 2048, SEQ_ = 2048, DEPTH_ = 4;
constexpr int NIN_ = 3072  , DFF_ = 5632;
constexpr float EPS_ = 1e-6f;
constexpr float LOG2E = 1.4426950408889634f;
constexpr float QSCALE_MLA = 0.07216878364870322f * LOG2E;
constexpr float QSCALE_DIL = 0.125f * LOG2E;

constexpr size_t MiB = 1u << 20;
constexpr size_t WS_CTL = 0;
constexpr size_t WS_ROPE = 1 * MiB;
constexpr size_t WS_ABAR = WS_ROPE + 512 * 1024;
constexpr size_t WS_A64 = WS_ABAR + 64 * 1024;
constexpr size_t WS_BB = 2 * MiB;
constexpr size_t WS_CT = 3 * MiB;
constexpr size_t WS_SST = 6 * MiB;
constexpr size_t WS_W = 8 * MiB;
constexpr size_t W_IN = 0, W_UQ = 12 * MiB, W_UKV = W_UQ + 3 * MiB / 2, W_GLU = W_UKV + 1 * MiB, W_O = W_GLU + 1 * MiB, W_GU = W_O + 8 * MiB, W_DN = W_GU + 44 * MiB, W_LAYER = W_DN + 22 * MiB;
constexpr size_t WS_X = WS_W + 4 * W_LAYER;
constexpr size_t WS_XB = WS_X + 64 * MiB;
constexpr size_t WS_MIX = WS_XB + 32 * MiB;
constexpr size_t WS_CQ = WS_MIX, WS_CKV = WS_CQ + 8 * MiB, WS_KPE = WS_CKV + 4 * MiB, WS_U = WS_KPE + 1 * MiB, WS_QD = WS_U + 16 * MiB, WS_KD = WS_QD + 8 * MiB, WS_VD = WS_KD + 8 * MiB,
                 WS_Q = WS_VD + 8 * MiB, WS_KV = WS_Q + 24 * MiB, WS_DP = WS_KV + 32 * MiB, WS_DLSE = WS_DP + 48 * MiB, WS_YCAT = WS_DLSE + 1 * MiB, WS_YG = WS_YCAT + 32 * MiB, WS_MIXEND = WS_YG + 8 * MiB;
constexpr size_t WS_HM = WS_MIX;
constexpr size_t WS_BBB = WS_MIXEND;
constexpr size_t WS_CTB = WS_BBB + 512 * 1024;
constexpr size_t WS_SS = WS_CTB + 512 * 1024;
constexpr size_t WS_END = WS_SS + 2 * MiB;
static_assert(WS_HM + (size_t)M_ * DFF_ * 2 <= WS_MIXEND, "HM overlay");
constexpr int SS_X = 0  , SS_Q = 5, SS_KV = 9, SS_SSM = 13, SS_MLA = 17, SS_DIL = 21, SS_X1 = 25, SS_N = 29;

constexpr int LDS_BYTES = 147456;

DI int opaque_tid() { int t = threadIdx.x; asm volatile("" : "+v"(t)); return t; }
typedef unsigned long long ssacc_t;
DI void ss_add(ssacc_t* p, float v) { atomicAdd(p, (ssacc_t)__float2ull_rn(v * 4294967296.f)); }
DI void ss_set(ssacc_t* p, float v) { *p = (ssacc_t)__float2ull_rn(v * 4294967296.f); }
DI float ss_get(const ssacc_t* p) { const ssacc_t v = *p; return (float)(unsigned)(v >> 32) + (float)(unsigned)(v & 0xffffffffull) * 2.3283064365386963e-10f; }
DI unsigned cvtpk(float lo, float hi) { f32x2 v = {lo, hi}; bf16x2_t b = __builtin_convertvector(v, bf16x2_t); return __builtin_bit_cast(unsigned, b); }
DI float bf2f(bf16_t b) { return __builtin_bit_cast(float, (unsigned)b << 16); }
DI float fexp2(float x) { return __builtin_amdgcn_exp2f(x); }
DI float sigmoidf_(float x) { return __builtin_amdgcn_rcpf(1.f + fexp2(-LOG2E * x)); }

namespace pg8 {
constexpr int BM = 256, BK = 64, HALF = 128, HTB = HALF * BK * 2, STAGE_BYTES = 8 * HTB, NXCD = 8, WGM = 8;
__host__ __device__ __forceinline__ int lds_byte(int r, int c) { const int st = (r >> 4) * 2 + (c >> 5), rr = r & 15, cc = c & 31, ob = rr * 64 + cc * 2; return st * 1024 + (ob ^ (((ob >> 9) & 1) << 5)); }
__host__ __device__ __forceinline__ void stage_rc(int b, int& R, int& C) { const int st = b / 1024, sb = b % 1024, swz = sb ^ (((sb >> 9) & 1) << 5); R = (st >> 1) * 16 + swz / 64; C = (st & 1) * 32 + (swz % 64) / 2; }
__host__ __device__ __forceinline__ int perm32(int rho) { const int n = rho >> 4, i = rho & 15; return 8 * (i >> 2) + 4 * n + (i & 3); }
struct Unit { int pm, pn; };
struct Gemm { const bf16_t* A; const bf16_t* Bt; int M, N, K; };
struct StaticOrder {
    int nM, nN, nwg, G, c;
    __host__ __device__ __forceinline__ void init(int M, int N, int G_, int c_) { nM = M / BM; nN = N / BM; nwg = nM * nN; G = G_; c = c_; }
    __host__ __device__ __forceinline__ bool next(int i, Unit& u) const {
        const long L = (long)i * G + c; if (L >= nwg) return false;
        int wgid = (int)L; { const int q = nwg / NXCD, r = nwg % NXCD, xcd = wgid % NXCD, off = wgid / NXCD; wgid = (xcd < r ? xcd * (q + 1) : r * (q + 1) + (xcd - r) * q) + off; }
        const int nig = WGM * nN, gid = wgid / nig, fm = gid * WGM, gsz = (nM - fm) < WGM ? (nM - fm) : WGM;
        u.pm = fm + ((wgid % nig) % gsz); u.pn = (wgid % nig) / gsz; return true;
    }
};
template <class Epi, class Sched, bool ALIGN_EPI, bool SP2>
__device__ __forceinline__ void gemm_phase(LAS unsigned char* lds, const Gemm g, const Sched& S, const Epi& E) {
    const int tid = opaque_tid(), wid = __builtin_amdgcn_readfirstlane(tid >> 6), lane = tid & 63, wr = wid >> 2, wc = wid & 3, fr = lane & 15, fq = lane >> 4;
    int K = g.K; asm volatile("" : "+s"(K)); const int nt = K / BK;
    unsigned voffA, voffB;
    { int R, C; stage_rc(tid * 16, R, C); const int Rb = Epi::PERM ? ((R & ~31) + perm32(R & 31)) : R;
      voffA = (unsigned)(R * K + C) * 2u; voffB = (unsigned)(Rb * K + C) * 2u; }
    const size_t rdelta = (size_t)64 * K * 2;
    const size_t kstep = (size_t)(BK * 2);
    const size_t hstep = (size_t)HALF * K * 2;
    const size_t tstep = 2 * hstep;
    const unsigned ldsw = (unsigned)wid * 1024u;
    const int aoff = lds_byte(wr * 64 + fr, fq * 8), boff = lds_byte(wc * 32 + fr, fq * 8);
#define PG8_SA(b, h) (((b) * 2 + (h)) * HTB)
#define PG8_SB(b, h) ((4 + (b) * 2 + (h)) * HTB)
#define PG8_STAGE(bufoff, gbase, voff) do { _Pragma("unroll") for (int _i = 0; _i < 2; ++_i) \
        __builtin_amdgcn_global_load_lds((const unsigned*)((const char*)(gbase) + _i * rdelta + (voff)), (LAS unsigned*)(lds + (bufoff) + ldsw + _i * 8192), 16, 0, 0); } while (0)
#define PG8_LDA(dst, b, h) do { _Pragma("unroll") for (int m = 0; m < 4; ++m) _Pragma("unroll") for (int k = 0; k < 2; ++k) dst[m][k] = *(const LAS bf16x8*)(lds + PG8_SA(b, h) + aoff + m * 2048 + k * 1024); } while (0)
#define PG8_LDB(dst, b, h) do { _Pragma("unroll") for (int n = 0; n < 2; ++n) _Pragma("unroll") for (int k = 0; k < 2; ++k) dst[n][k] = *(const LAS bf16x8*)(lds + PG8_SB(b, h) + boff + n * 2048 + k * 1024); } while (0)
#define PG8_MMA(ai, bj, At, Bt) do { __builtin_amdgcn_s_setprio(1); _Pragma("unroll") for (int m = 0; m < 4; ++m) _Pragma("unroll") for (int n = 0; n < 2; ++n) _Pragma("unroll") for (int k = 0; k < 2; ++k) \
        acc[ai][bj][m][n] = __builtin_amdgcn_mfma_f32_16x16x32_bf16(Bt[n][k], At[m][k], acc[ai][bj][m][n], 0, 0, 0); __builtin_amdgcn_s_setprio(0); } while (0)
#define PG8_WAIT_V(n) asm volatile("s_waitcnt vmcnt(" #n ")" ::: "memory")
#define PG8_WAIT_L(n) asm volatile("s_waitcnt lgkmcnt(" #n ")" ::: "memory")
#define PG8_BAR __builtin_amdgcn_s_barrier()
#define PG8_SCHED __builtin_amdgcn_sched_barrier(0)
    Unit cur, nxt; int ui = 0;
    if (!S.next(0, cur)) return;
    f32x4 acc[2][2][4][2];
#pragma unroll
    for (int a = 0; a < 2; ++a)
#pragma unroll
        for (int b = 0; b < 2; ++b)
#pragma unroll
            for (int m = 0; m < 4; ++m)
#pragma unroll
                for (int n = 0; n < 2; ++n) acc[a][b][m][n] = (f32x4){0.f, 0.f, 0.f, 0.f};
    bf16x8 At[4][2], B0[2][2], B1[2][2];
    const char* cA = (const char*)g.A + (size_t)cur.pm * tstep; const char* cB = (const char*)g.Bt + (size_t)cur.pn * tstep;
    if constexpr (SP2) {
        PG8_STAGE(PG8_SB(0, 0), cB, voffB); PG8_STAGE(PG8_SB(0, 1), cB + hstep, voffB); PG8_STAGE(PG8_SA(0, 0), cA, voffA); PG8_STAGE(PG8_SA(0, 1), cA + hstep, voffA);
        if (wr == 1) PG8_BAR;
        PG8_WAIT_V(2); PG8_BAR;
        PG8_STAGE(PG8_SB(1, 0), cB + kstep, voffB); PG8_STAGE(PG8_SA(1, 0), cA + kstep, voffA); PG8_STAGE(PG8_SB(1, 1), cB + hstep + kstep, voffB);
        PG8_WAIT_V(6); PG8_BAR;
    }
    for (;;) {
        const bool has_next = S.next(ui + 1, nxt);
        const char* nA = has_next ? (const char*)g.A + (size_t)nxt.pm * tstep : cA; const char* nB = has_next ? (const char*)g.Bt + (size_t)nxt.pn * tstep : cB;
        for (int t = 0; t < nt; t += 2) {
            if constexpr (Epi::HOOK) { if (t == Epi::T1 || t == Epi::T2) E.hook(acc, ui, t, wr, fr); }
            const bool last = (t == nt - 2);
            const char* a1 = cA + (size_t)(t + 1) * kstep;
            const char* a2 = last ? nA : cA + (size_t)(t + 2) * kstep; const char* b2 = last ? nB : cB + (size_t)(t + 2) * kstep;
            const char* a3 = a2 + kstep; const char* b3 = b2 + kstep;
            PG8_LDB(B0, 0, 0); PG8_LDB(B1, 0, 1); PG8_SCHED; PG8_LDA(At, 0, 0); PG8_STAGE(PG8_SA(1, 1), a1 + hstep, voffA);
            PG8_WAIT_V(8); PG8_WAIT_L(0); PG8_BAR; PG8_MMA(0, 0, At, B0); PG8_MMA(0, 1, At, B1); PG8_BAR; PG8_SCHED;
            PG8_LDA(At, 0, 1); PG8_STAGE(PG8_SB(0, 0), b2, voffB); PG8_STAGE(PG8_SB(0, 1), b2 + hstep, voffB); PG8_STAGE(PG8_SA(0, 0), a2, voffA);
            PG8_WAIT_V(8); PG8_WAIT_L(0); PG8_BAR; PG8_MMA(1, 0, At, B0); PG8_MMA(1, 1, At, B1); PG8_BAR; PG8_SCHED;
            PG8_LDB(B0, 1, 0); PG8_LDB(B1, 1, 1); PG8_SCHED; PG8_LDA(At, 1, 0); PG8_STAGE(PG8_SA(0, 1), a2 + hstep, voffA);
            PG8_WAIT_V(8); PG8_WAIT_L(0); PG8_BAR; PG8_MMA(0, 0, At, B0); PG8_MMA(0, 1, At, B1); PG8_BAR; PG8_SCHED;
            PG8_LDA(At, 1, 1); PG8_STAGE(PG8_SB(1, 0), b3, voffB); PG8_STAGE(PG8_SB(1, 1), b3 + hstep, voffB); PG8_STAGE(PG8_SA(1, 0), a3, voffA);
            PG8_WAIT_V(8); PG8_WAIT_L(0); PG8_BAR; PG8_MMA(1, 0, At, B0); PG8_MMA(1, 1, At, B1); PG8_BAR; PG8_SCHED;
        }
        if constexpr (ALIGN_EPI) { if (wr == 0) PG8_BAR; }
        E(acc, cur, wr, wc, fr, fq);
        if (!has_next) break;
#pragma unroll
        for (int a = 0; a < 2; ++a)
#pragma unroll
            for (int b = 0; b < 2; ++b)
#pragma unroll
                for (int m = 0; m < 4; ++m)
#pragma unroll
                    for (int n = 0; n < 2; ++n) acc[a][b][m][n] = (f32x4){0.f, 0.f, 0.f, 0.f};
        cur = nxt; cA = nA; cB = nB; ++ui;
        if constexpr (ALIGN_EPI) { if (wr == 1) PG8_BAR; }
    }
    PG8_WAIT_V(0);
    if constexpr (!ALIGN_EPI) { if (wr == 0) PG8_BAR; }
    PG8_BAR;
#undef PG8_SA
#undef PG8_SB
#undef PG8_STAGE
#undef PG8_LDA
#undef PG8_LDB
#undef PG8_MMA
#undef PG8_WAIT_V
#undef PG8_WAIT_L
#undef PG8_BAR
#undef PG8_SCHED
}
}
using pg8::Unit;
typedef f32x4 Acc[2][2][4][2];

struct Params {
    const float* in[26];
    float* out;
    unsigned char* ws;
};

typedef const __attribute__((address_space(4))) Params* PP;
DI PP getpp() { PP pp = (PP)__builtin_amdgcn_kernarg_segment_ptr(); asm volatile("" : "+s"(pp)); return pp; }
DI float quad_sum(float s) { s += __shfl_xor(s, 16); s += __shfl_xor(s, 32); return s; }
DI float sq8(const f32x4& a, const f32x4& b) { return (a[0] * a[0] + a[1] * a[1]) + (a[2] * a[2] + a[3] * a[3]) + (b[0] * b[0] + b[1] * b[1]) + (b[2] * b[2] + b[3] * b[3]); }
DI u32x4 pack8(const f32x4& a, const f32x4& b) { u32x4 w; w.x = cvtpk(a[0], a[1]); w.y = cvtpk(a[2], a[3]); w.z = cvtpk(b[0], b[1]); w.w = cvtpk(b[2], b[3]); return w; }
DI void rope8(f32x4& a, f32x4& b, const float* rope, int pos, int j0) {
    const f32x4 cs0 = *(const f32x4*)(rope + ((size_t)pos * 32 + j0) * 2), cs1 = *(const f32x4*)(rope + ((size_t)pos * 32 + j0 + 2) * 2);
    f32x4 o0, o1;
    o0[0] = a[0] * cs0[0] - a[1] * cs0[1]; o0[1] = a[1] * cs0[0] + a[0] * cs0[1];
    o0[2] = a[2] * cs0[2] - a[3] * cs0[3]; o0[3] = a[3] * cs0[2] + a[2] * cs0[3];
    o1[0] = b[0] * cs1[0] - b[1] * cs1[1]; o1[1] = b[1] * cs1[0] + b[0] * cs1[1];
    o1[2] = b[2] * cs1[2] - b[3] * cs1[3]; o1[3] = b[3] * cs1[2] + b[2] * cs1[3];
    a = o0; b = o1;
}

struct EpiInProj {
    static constexpr bool PERM = true, HOOK = false; static constexpr int T1 = -1, T2 = -1;
    unsigned char* ws; int l;
    DI void hook(Acc&, int, int, int, int) const {}
    DI void operator()(const Acc& acc, const Unit& u, int wr, int wc, int fr, int fq) const {
        const int pn = u.pn;
        const ssacc_t* ssx = (const ssacc_t*)(ws + WS_SS) + (size_t)(SS_X + l) * M_; const float* rope = (const float*)(ws + WS_ROPE);
        bf16_t *CQ = (bf16_t*)(ws + WS_CQ), *CKV = (bf16_t*)(ws + WS_CKV), *QD = (bf16_t*)(ws + WS_QD), *KD = (bf16_t*)(ws + WS_KD), *VD = (bf16_t*)(ws + WS_VD), *KPE = (bf16_t*)(ws + WS_KPE);
        float* U = (float*)(ws + WS_U); ssacc_t *ssq = (ssacc_t*)(ws + WS_SS) + (size_t)(SS_Q + l) * M_, *sskv = (ssacc_t*)(ws + WS_SS) + (size_t)(SS_KV + l) * M_;
#pragma unroll
        for (int ai = 0; ai < 2; ++ai)
#pragma unroll
            for (int m = 0; m < 4; ++m) {
                asm volatile("" ::: "memory");
                const int row = u.pm * 256 + ai * 128 + wr * 64 + m * 16 + fr;
                const float rs = rsqrtf(ss_get(ssx + row) * (1.f / 2048.f) + EPS_);
                float sq = 0.f;
#pragma unroll
                for (int bj = 0; bj < 2; ++bj) {
                    f32x4 v0 = acc[ai][bj][m][0] * rs, v1 = acc[ai][bj][m][1] * rs;
                    const int ct = bj * 128 + wc * 32 + 8 * fq;
                    if (pn <= 1) { *(u32x4*)(CQ + (size_t)row * 512 + pn * 256 + ct) = pack8(v0, v1); sq += sq8(v0, v1); }
                    else if (pn == 2) { *(u32x4*)(CKV + (size_t)row * 256 + ct) = pack8(v0, v1); sq += sq8(v0, v1); }
                    else if (pn <= 4) { float* p = U + (size_t)row * 512 + (pn - 3) * 256 + ct; *(f32x4*)p = v0; *(f32x4*)(p + 4) = v1; }
                    else if (pn <= 6) { v0 = v0 * QSCALE_DIL; v1 = v1 * QSCALE_DIL; *(u32x4*)(QD + (size_t)row * 512 + (pn - 5) * 256 + ct) = pack8(v0, v1); }
                    else if (pn <= 8) { *(u32x4*)(KD + (size_t)row * 512 + (pn - 7) * 256 + ct) = pack8(v0, v1); }
                    else if (pn <= 10) { *(u32x4*)(VD + (size_t)row * 512 + (pn - 9) * 256 + ct) = pack8(v0, v1); }
                    else { if (ct < 64) { rope8(v0, v1, rope, row & 2047, ct >> 1); *(u32x4*)(KPE + (size_t)row * 64 + ct) = pack8(v0, v1); } }
                }
                if (pn <= 2) { sq = quad_sum(sq); if (fq == 0) ss_add((pn <= 1 ? ssq : sskv) + row, sq); }
            }
    }
};
struct EpiQUp {
    static constexpr bool PERM = true, HOOK = false; static constexpr int T1 = -1, T2 = -1;
    const ssacc_t* ssq; const float* rope; bf16_t* Q;
    DI void hook(Acc&, int, int, int, int) const {}
    DI void operator()(const Acc& acc, const Unit& u, int wr, int wc, int fr, int fq) const {
#pragma unroll
        for (int ai = 0; ai < 2; ++ai)
#pragma unroll
            for (int m = 0; m < 4; ++m) {
                asm volatile("" ::: "memory");
                const int row = u.pm * 256 + ai * 128 + wr * 64 + m * 16 + fr;
                const float rs = rsqrtf(ss_get(ssq + row) * (1.f / 512.f) + EPS_) * QSCALE_MLA;
#pragma unroll
                for (int bj = 0; bj < 2; ++bj) {
                    f32x4 v0 = acc[ai][bj][m][0] * rs, v1 = acc[ai][bj][m][1] * rs;
                    const int c0 = u.pn * 256 + bj * 128 + wc * 32 + 8 * fq;
                    const int w = c0 % 192;
                    if (w >= 128) rope8(v0, v1, rope, row & 2047, (w - 128) >> 1);
                    *(u32x4*)(Q + (size_t)row * 1536 + c0) = pack8(v0, v1);
                }
            }
    }
};
struct EpiKvUp {
    static constexpr bool PERM = true, HOOK = false; static constexpr int T1 = -1, T2 = -1;
    const ssacc_t* sskv; bf16_t* KV;
    DI void hook(Acc&, int, int, int, int) const {}
    DI void operator()(const Acc& acc, const Unit& u, int wr, int wc, int fr, int fq) const {
#pragma unroll
        for (int ai = 0; ai < 2; ++ai)
#pragma unroll
            for (int m = 0; m < 4; ++m) {
                asm volatile("" ::: "memory");
                const int row = u.pm * 256 + ai * 128 + wr * 64 + m * 16 + fr;
                const float rs = rsqrtf(ss_get(sskv + row) * (1.f / 256.f) + EPS_);
#pragma unroll
                for (int bj = 0; bj < 2; ++bj) {
                    const f32x4 v0 = acc[ai][bj][m][0] * rs, v1 = acc[ai][bj][m][1] * rs;
                    const int c0 = u.pn * 256 + bj * 128 + wc * 32 + 8 * fq;
                    *(u32x4*)(KV + (size_t)row * 2048 + c0) = pack8(v0, v1);
                }
            }
    }
};
struct EpiGlu {
    static constexpr bool PERM = true, HOOK = false; static constexpr int T1 = -1, T2 = -1;
    const float* bglu; bf16_t* YCAT; ssacc_t* ss;
    DI void hook(Acc&, int, int, int, int) const {}
    DI void operator()(const Acc& acc, const Unit& u, int wr, int wc, int fr, int fq) const {
#pragma unroll
        for (int ai = 0; ai < 2; ++ai)
#pragma unroll
            for (int m = 0; m < 4; ++m) {
                asm volatile("" ::: "memory");
                const int row = u.pm * 256 + ai * 128 + wr * 64 + m * 16 + fr;
                float sq = 0.f;
#pragma unroll
                for (int bj = 0; bj < 2; ++bj) {
                    const f32x4 v0 = acc[ai][bj][m][0], v1 = acc[ai][bj][m][1];
                    const int i0 = (u.pn * 256 + bj * 128 + wc * 32 + 8 * fq) >> 1;
                    const f32x4 b1 = *(const f32x4*)(bglu + i0), b2 = *(const f32x4*)(bglu + 512 + i0);
                    const float o0 = (v0[0] + b1[0]) * sigmoidf_(v0[1] + b2[0]), o1 = (v0[2] + b1[1]) * sigmoidf_(v0[3] + b2[1]);
                    const float o2 = (v1[0] + b1[2]) * sigmoidf_(v1[1] + b2[2]), o3 = (v1[2] + b1[3]) * sigmoidf_(v1[3] + b2[3]);
                    sq += (o0 * o0 + o1 * o1) + (o2 * o2 + o3 * o3);
                    u32x2 w; w.x = cvtpk(o0, o1); w.y = cvtpk(o2, o3);
                    *(u32x2*)(YCAT + (size_t)row * 2048 + i0) = w;
                }
                sq = quad_sum(sq); if (fq == 0) ss_add(ss + row, sq);
            }
    }
};
struct EpiWo {
    static constexpr bool PERM = true, HOOK = true; static constexpr int T1 = 8, T2 = 24;
    unsigned char* ws; int l; const float* xin;
    const LAS float* FT;
    DI void hook(Acc& acc, int ui, int t, int wr, int fr) const {
        const LAS float* ft = FT + (ui * 2 + (t == T2 ? 1 : 0)) * 256 + wr * 64 + fr;
#pragma unroll
        for (int ai = 0; ai < 2; ++ai)
#pragma unroll
            for (int m = 0; m < 4; ++m) {
                const float f = ft[ai * 128 + m * 16];
#pragma unroll
                for (int bj = 0; bj < 2; ++bj) { acc[ai][bj][m][0] = acc[ai][bj][m][0] * f; acc[ai][bj][m][1] = acc[ai][bj][m][1] * f; }
            }
    }
    DI void operator()(const Acc& acc, const Unit& u, int wr, int wc, int fr, int fq) const {
        const ssacc_t* ss_dil = (const ssacc_t*)(ws + WS_SS) + (size_t)(SS_DIL + l) * M_; ssacc_t* ssx1 = (ssacc_t*)(ws + WS_SS) + (size_t)(SS_X1 + l) * M_;
        float* X = (float*)(ws + WS_X); bf16_t* XB = (bf16_t*)(ws + WS_XB);
#pragma unroll
        for (int ai = 0; ai < 2; ++ai)
#pragma unroll
            for (int m = 0; m < 4; ++m) {
                asm volatile("" ::: "memory");
                const int row = u.pm * 256 + ai * 128 + wr * 64 + m * 16 + fr;
                const float rs = rsqrtf(ss_get(ss_dil + row) * (1.f / 512.f) + EPS_);
                float sq = 0.f;
#pragma unroll
                for (int bj = 0; bj < 2; ++bj) {
                    const size_t off = (size_t)row * 2048 + u.pn * 256 + bj * 128 + wc * 32 + 8 * fq;
                    const f32x4 v0 = *(const f32x4*)(xin + off) + acc[ai][bj][m][0] * rs, v1 = *(const f32x4*)(xin + off + 4) + acc[ai][bj][m][1] * rs;
                    *(f32x4*)(X + off) = v0; *(f32x4*)(X + off + 4) = v1; *(u32x4*)(XB + off) = pack8(v0, v1); sq += sq8(v0, v1);
                }
                sq = quad_sum(sq); if (fq == 0) ss_add(ssx1 + row, sq);
            }
    }
};
struct EpiGateUp {
    static constexpr bool PERM = true, HOOK = false; static constexpr int T1 = -1, T2 = -1;
    const ssacc_t* ssx1; bf16_t* HM;
    DI void hook(Acc&, int, int, int, int) const {}
    DI void operator()(const Acc& acc, const Unit& u, int wr, int wc, int fr, int fq) const {
#pragma unroll
        for (int ai = 0; ai < 2; ++ai)
#pragma unroll
            for (int m = 0; m < 4; ++m) {
                asm volatile("" ::: "memory");
                const int row = u.pm * 256 + ai * 128 + wr * 64 + m * 16 + fr;
                const float rs = rsqrtf(ss_get(ssx1 + row) * (1.f / 2048.f) + EPS_);
#pragma unroll
                for (int bj = 0; bj < 2; ++bj) {
                    const f32x4 v0 = acc[ai][bj][m][0] * rs, v1 = acc[ai][bj][m][1] * rs;
                    const int i0 = (u.pn * 256 + bj * 128 + wc * 32 + 8 * fq) >> 1;
                    const float o0 = v0[0] * sigmoidf_(v0[0]) * v0[1], o1 = v0[2] * sigmoidf_(v0[2]) * v0[3];
                    const float o2 = v1[0] * sigmoidf_(v1[0]) * v1[1], o3 = v1[2] * sigmoidf_(v1[2]) * v1[3];
                    u32x2 w; w.x = cvtpk(o0, o1); w.y = cvtpk(o2, o3);
                    *(u32x2*)(HM + (size_t)row * DFF_ + i0) = w;
                }
            }
    }
};
struct EpiDown {
    static constexpr bool PERM = true, HOOK = false; static constexpr int T1 = -1, T2 = -1;
    float* X; bf16_t* XB; ssacc_t* ssx;
    DI void hook(Acc&, int, int, int, int) const {}
    DI void operator()(const Acc& acc, const Unit& u, int wr, int wc, int fr, int fq) const {
#pragma unroll
        for (int ai = 0; ai < 2; ++ai)
#pragma unroll
            for (int m = 0; m < 4; ++m) {
                asm volatile("" ::: "memory");
                const int row = u.pm * 256 + ai * 128 + wr * 64 + m * 16 + fr;
                float sq = 0.f;
#pragma unroll
                for (int bj = 0; bj < 2; ++bj) {
                    const size_t off = (size_t)row * 2048 + u.pn * 256 + bj * 128 + wc * 32 + 8 * fq;
                    const f32x4 v0 = *(const f32x4*)(X + off) + acc[ai][bj][m][0], v1 = *(const f32x4*)(X + off + 4) + acc[ai][bj][m][1];
                    *(f32x4*)(X + off) = v0; *(f32x4*)(X + off + 4) = v1; *(u32x4*)(XB + off) = pack8(v0, v1); sq += sq8(v0, v1);
                }
                sq = quad_sum(sq); if (fq == 0) ss_add(ssx + row, sq);
            }
    }
};

template <class Epi>
DI void run_gemm(LAS unsigned char* lds, const bf16_t* A, const bf16_t* Bt, int N, int K, const Epi& E) {
    pg8::Gemm g{A, Bt, M_, N, K}; pg8::StaticOrder S; S.init(M_, N, (int)gridDim.x, (int)blockIdx.x);
#if !defined(NO_GEMM)
    pg8::gemm_phase<Epi, pg8::StaticOrder, true, true>(lds, g, S, E);
#endif
    __syncthreads();
}

DI float wave_sum(float v) {
#pragma unroll
    for (int o = 1; o < 64; o <<= 1) v += __shfl_xor(v, o);
    return v;
}
template <int KIND> DI int map_n(int n) {
    if (KIND == 0) {
        if (n < 768) return n;
        if (n < 832) { const int j = n - 768; return 2816 + (j < 32 ? 2 * j : 2 * (j - 32) + 1); }
        return n - 64;
    }
    if (KIND == 1) {
        const int hd = n / 192, w = n % 192;
        if (w < 128) return n;
        const int j = w - 128; return hd * 192 + 128 + (j < 32 ? 2 * j : 2 * (j - 32) + 1);
    }
    if (KIND == 3) return n < 512 ? 2 * n : 2 * (n - 512) + 1;
    if (KIND == 5) return 2 * n;
    if (KIND == 6) return 2 * n + 1;
    return n;
}
template <int KIND>
DI void transpose_item(const float* W, int K, int N, bf16_t* WT, int ldk, const float* g0, const float* g1, const float* g2, LAS float* scr, int item, int lane) {
    const int nblk = N / 32, kb = item / nblk, nb = item % nblk, k0 = 64 * kb, n0 = 32 * nb;
    f32x4 tv[8];
#pragma unroll
    for (int i = 0; i < 8; ++i) tv[i] = *(const f32x4*)(W + (size_t)(k0 + 8 * i + (lane >> 3)) * N + n0 + 4 * (lane & 7));
#pragma unroll
    for (int i = 0; i < 8; ++i) {
        const int kk = 8 * i + (lane >> 3), k = k0 + kk;
        float gn = 1.f;
        if (KIND == 0 || KIND == 1 || KIND == 2 || KIND == 5 || KIND == 6) gn = g0[k];
        if (KIND == 4) gn = k < 1024 ? g0[k] : (k < 1536 ? g1[k - 1024] : g2[k - 1536]);
        LAS float* d = scr + kk * 33 + 4 * (lane & 7);
        d[0] = tv[i][0] * gn; d[1] = tv[i][1] * gn; d[2] = tv[i][2] * gn; d[3] = tv[i][3] * gn;
    }
    asm volatile("s_waitcnt lgkmcnt(0)" ::: "memory");
    int kd0 = k0;
    if (KIND == 4) kd0 = k0 < 1024 ? k0 + 512 : (k0 < 1536 ? k0 - 1024 : k0);
    const int c = lane & 7;
#pragma unroll
    for (int j = 0; j < 4; ++j) { const int n = (lane >> 3) + 8 * j; const LAS float* s = scr + (8 * c) * 33 + n;
        u32x4 o; o.x = cvtpk(s[0 * 33], s[1 * 33]); o.y = cvtpk(s[2 * 33], s[3 * 33]); o.z = cvtpk(s[4 * 33], s[5 * 33]); o.w = cvtpk(s[6 * 33], s[7 * 33]);
        *(u32x4*)(WT + (size_t)map_n<KIND>(n0 + n) * ldk + kd0 + 8 * c) = o; }
    asm volatile("s_waitcnt lgkmcnt(0)" ::: "memory");
}

DI void prologue(PP p, LAS unsigned char* lds) {
    const int tid = opaque_tid(), lane = tid & 63, wid = __builtin_amdgcn_readfirstlane(tid >> 6);
    const int gw = blockIdx.x * 8 + wid, NGW = gridDim.x * 8;
    const int gt = blockIdx.x * 512 + tid, NGT = gridDim.x * 512;
    unsigned char* ws = p->ws;
    { ssacc_t* ss = (ssacc_t*)(ws + WS_SS); for (int i = gt; i < (SS_N - 1) * M_; i += NGT) ss[M_ + i] = 0ull; }
    {
        const float* x = p->in[0]; bf16_t* XB = (bf16_t*)(ws + WS_XB); ssacc_t* ss = (ssacc_t*)(ws + WS_SS);
        for (int m = gw; m < M_; m += NGW) {
            const f32x4* xr = (const f32x4*)(x + (size_t)m * D_) + lane * 2; float s = 0.f;
#pragma unroll
            for (int j = 0; j < 4; ++j) { const f32x4 a = xr[128 * j], b = xr[128 * j + 1]; s += sq8(a, b); *(u32x4*)(XB + (size_t)m * D_ + j * 512 + lane * 8) = pack8(a, b); }
            s = wave_sum(s); if (lane == 0) ss_set(ss + m, s);
        }
    }
    {
        float* rope = (float*)(ws + WS_ROPE);
        for (int i = gt; i < 2048 * 32; i += NGT) {
            const int pos = i >> 5, j = i & 31;
            const double inv = exp(-(double)j * (9.210340371976184 / 32.0));
            double rev = (double)pos * inv * 0.15915494309189535; rev -= rint(rev);
            float sn, cs; sincosf((float)(rev * 6.283185307179586), &sn, &cs);
            rope[2 * i] = cs; rope[2 * i + 1] = sn;
        }
    }
    {
        const float *a_re = p->in[7], *a_im = p->in[8], *b_re = p->in[9], *b_im = p->in[10], *c_re = p->in[11], *c_im = p->in[12], *log_dt = p->in[14];
        float* ABAR = (float*)(ws + WS_ABAR); float* A64 = (float*)(ws + WS_A64); float* BB = (float*)(ws + WS_BB); float* CT = (float*)(ws + WS_CT);
        for (int i = gt; i < 4 * 32 * 64; i += NGT) {
            const int lg = i >> 6;
            const float lre = fminf(a_re[i], -1e-4f), lim = a_im[i];
            const float dt = __expf(log_dt[lg]);
            const double xr = (double)lre * (double)dt, th = (double)lim * (double)dt;
            double rev = th * 0.15915494309189535; rev -= rint(rev);
            const float r = (float)(rev * 6.283185307179586);
            float sn, cs; sincosf(r, &sn, &cs);
            const float ex = __expf((float)xr), em1 = expm1f((float)xr);
            ABAR[2 * i] = ex * cs; ABAR[2 * i + 1] = ex * sn;
            { double rev2 = th * 64.0 * 0.15915494309189535; rev2 -= rint(rev2); float s2, c2; sincosf((float)(rev2 * 6.283185307179586), &s2, &c2);
              const float e2 = __expf((float)(xr * 64.0)); A64[2 * i] = e2 * c2; A64[2 * i + 1] = e2 * s2; }
            float sh, ch; sincosf(0.5f * r, &sh, &ch);
            const float dre = em1 * cs - 2.f * sh * sh, dim = ex * sn;
            const float den = 1.f / (lre * lre + lim * lim);
            const float qre = (dre * lre + dim * lim) * den, qim = (dim * lre - dre * lim) * den;
            for (int pp = 0; pp < 16; ++pp) {
                const float br = b_re[(size_t)i * 16 + pp], bi = b_im[(size_t)i * 16 + pp];
                BB[((size_t)i * 16 + pp) * 2] = qre * br - qim * bi; BB[((size_t)i * 16 + pp) * 2 + 1] = qre * bi + qim * br;
                { bf16_t* BBb = (bf16_t*)(ws + WS_BBB); const int n = i & 63;
                  BBb[((size_t)lg * 128 + 2 * n) * 16 + pp] = (bf16_t)(cvtpk(qre * br - qim * bi, 0.f) & 0xffffu);
                  BBb[((size_t)lg * 128 + 2 * n + 1) * 16 + pp] = (bf16_t)(cvtpk(qre * bi + qim * br, 0.f) & 0xffffu); }
            }
        }
        for (int i = gt; i < 4 * 32 * 4 * 16 * 32; i += NGT) {
            const int kk = i & 31, pp = (i >> 5) & 15, kq = (i >> 9) & 3, lg = i >> 11, k = 32 * kq + kk;
            CT[i] = k < 64 ? c_re[((size_t)lg * 16 + pp) * 64 + k] : -c_im[((size_t)lg * 16 + pp) * 64 + (k - 64)];
        }
        for (int i = gt; i < 4 * 32 * 16 * 128; i += NGT) {
            const int k = i & 127, pp = (i >> 7) & 15, lg = i >> 11, n = k >> 1;
            const float v = (k & 1) ? -c_im[((size_t)lg * 16 + pp) * 64 + n] : c_re[((size_t)lg * 16 + pp) * 64 + n];
            ((bf16_t*)(ws + WS_CTB))[i] = (bf16_t)(cvtpk(v, 0.f) & 0xffffu);
        }
    }
}

DI void convert_weights(PP p, LAS unsigned char* lds, int l, int worker, int nworkers) {
    const int tid = opaque_tid(), lane = tid & 63, wid = __builtin_amdgcn_readfirstlane(tid >> 6);
    unsigned char* ws = p->ws;
    LAS float* scr = (LAS float*)(lds + wid * 16384);
    constexpr int I_IN = 32 * 90, I_UQ = 8 * 48, I_UKV = 4 * 64, I_GLU = 8 * 32, I_O = 32 * 64, I_G = 32 * 176, I_DN = 88 * 64;
    constexpr int I_LAYER = I_IN + I_UQ + I_UKV + I_GLU + I_O + 2 * I_G + I_DN;
    unsigned char* wl = ws + WS_W + (size_t)l * W_LAYER;
    for (int it = worker; it < I_LAYER; it += nworkers) {
        int r = it;
        if (r < I_IN) { transpose_item<0>(p->in[2] + (size_t)l * 2048 * 2880, 2048, 2880, (bf16_t*)(wl + W_IN), 2048, p->in[1] + l * 2048, nullptr, nullptr, scr, r, lane); continue; } r -= I_IN;
        if (r < I_UQ) { transpose_item<1>(p->in[4] + (size_t)l * 512 * 1536, 512, 1536, (bf16_t*)(wl + W_UQ), 512, p->in[3] + l * 512, nullptr, nullptr, scr, r, lane); continue; } r -= I_UQ;
        if (r < I_UKV) { transpose_item<2>(p->in[6] + (size_t)l * 256 * 2048, 256, 2048, (bf16_t*)(wl + W_UKV), 256, p->in[5] + l * 256, nullptr, nullptr, scr, r, lane); continue; } r -= I_UKV;
        if (r < I_GLU) { transpose_item<3>(p->in[15] + (size_t)l * 512 * 1024, 512, 1024, (bf16_t*)(wl + W_GLU), 512, nullptr, nullptr, nullptr, scr, r, lane); continue; } r -= I_GLU;
        if (r < I_O) { transpose_item<4>(p->in[20] + (size_t)l * 2048 * 2048, 2048, 2048, (bf16_t*)(wl + W_O), 2048, p->in[17] + l * 1024, p->in[18] + l * 512, p->in[19] + l * 512, scr, r, lane); continue; } r -= I_O;
        if (r < I_G) { transpose_item<5>(p->in[22] + (size_t)l * 2048 * DFF_, 2048, DFF_, (bf16_t*)(wl + W_GU), 2048, p->in[21] + l * 2048, nullptr, nullptr, scr, r, lane); continue; } r -= I_G;
        if (r < I_G) { transpose_item<6>(p->in[23] + (size_t)l * 2048 * DFF_, 2048, DFF_, (bf16_t*)(wl + W_GU), 2048, p->in[21] + l * 2048, nullptr, nullptr, scr, r, lane); continue; } r -= I_G;
        transpose_item<7>(p->in[24] + (size_t)l * DFF_ * 2048, DFF_, 2048, (bf16_t*)(wl + W_DN), DFF_, nullptr, nullptr, nullptr, scr, r, lane);
    }
}

DI int crow(int i, int h) { return (i & 3) + 8 * (i >> 2) + 4 * h; }
DI bf16x8 pack_step(const f32x16& x, int s) {
    u32x4 w; w.x = cvtpk(x[8 * s], x[8 * s + 1]); w.y = cvtpk(x[8 * s + 2], x[8 * s + 3]); w.z = cvtpk(x[8 * s + 4], x[8 * s + 5]); w.w = cvtpk(x[8 * s + 6], x[8 * s + 7]);
    return __builtin_bit_cast(bf16x8, w);
}
typedef short v4i16_t __attribute__((ext_vector_type(4)));
DI s16x4 vtr(const LAS unsigned char* p) { return __builtin_bit_cast(s16x4, __builtin_amdgcn_ds_read_tr16_b64_v4i16((LAS v4i16_t*)p)); }
#define MFMA32(a, b, c) __builtin_amdgcn_mfma_f32_32x32x16_bf16((a), (b), (c), 0, 0, 0)

struct AttnPtrs {
    unsigned char* ws; int l;
    DI const bf16_t* Q() const { return (const bf16_t*)(ws + WS_Q); }
    DI const bf16_t* KV() const { return (const bf16_t*)(ws + WS_KV); }
    DI const bf16_t* KPE() const { return (const bf16_t*)(ws + WS_KPE); }
    DI const bf16_t* QD() const { return (const bf16_t*)(ws + WS_QD); }
    DI const bf16_t* KD() const { return (const bf16_t*)(ws + WS_KD); }
    DI const bf16_t* VD() const { return (const bf16_t*)(ws + WS_VD); }
    DI bf16_t* YCAT() const { return (bf16_t*)(ws + WS_YCAT); }
    DI ssacc_t* ss_mla() const { return (ssacc_t*)(ws + WS_SS) + (size_t)(SS_MLA + l) * M_; }
    DI bf16_t* DP() const { return (bf16_t*)(ws + WS_DP); }
    DI float* DLSE() const { return (float*)(ws + WS_DLSE); }
};

template <int MODE, bool ATOM = true>
DI void attn_unit(LAS unsigned char* lds, const AttnPtrs& P, int b, int hd, int fi0, int dmul, int r0, int pat, int t_begin, int t_end) {
    constexpr int DQK = MODE == 0 ? 192 : 64, DV = MODE == 0 ? 128 : 64;
    constexpr int KSTR = (DQK + 8) * 2, VSTR = DV * 2 + 32;
    constexpr int CPK = DQK / 8, CPV = DV / 8, NKR = 128 * CPK / 512, NVR = 128 * CPV / 512;
    constexpr int NKK = DQK / 16, NDV = DV / 32;
    constexpr int span = MODE == 0 ? (1 << 30) : 128;
    LAS unsigned char* Ks = lds; LAS unsigned char* Vs = lds + 128 * KSTR;
    const int tid = opaque_tid(), lane = tid & 63, wid = __builtin_amdgcn_readfirstlane(tid >> 6), r = lane & 31, h = lane >> 5, rg = wid & 3, kh = wid >> 2;
    const int fq_ = fi0 + rg * 32 + r;
    const size_t tokq = (size_t)b * 2048 + (size_t)fq_ * dmul + r0;
    constexpr int NQF = MODE == 0 ? 1 : NKK;
    bf16x8 qf[NQF];
    LAS unsigned char* Qs = lds + 128 * KSTR + 128 * VSTR;
    const LAS unsigned char* Qw = Qs + (rg * 32 + r) * KSTR + h * 16;
    if (MODE == 0) {
        const bf16_t* qp = P.Q() + ((size_t)b * 2048 + fi0 + (tid >> 2)) * 1536 + hd * 192 + (tid & 3) * 8;
#pragma unroll
        for (int i = 0; i < 6; ++i) { const u32x4 v = *(const u32x4*)(qp + i * 32); *(LAS u32x4*)(Qs + (tid >> 2) * KSTR + (tid & 3) * 16 + i * 64) = v; }
    } else {
        const bf16_t* qp = P.QD() + tokq * 512 + hd * 64;
#pragma unroll
        for (int kk = 0; kk < NQF; ++kk) qf[kk] = *(const bf16x8*)(qp + kk * 16 + 8 * h);
    }
    f32x16 o[NDV];
#pragma unroll
    for (int d = 0; d < NDV; ++d)
#pragma unroll
        for (int i = 0; i < 16; ++i) o[d][i] = 0.f;
    float mrun = -INFINITY, lrun = 0.f;
    u32x4 kreg[NKR], vreg[NVR];
    const int lkey = tid >> 2, lq = tid & 3;
    const bf16_t* kp0; const bf16_t* kp1;
    if (MODE == 0) { const size_t tok = (size_t)b * 2048 + t_begin * 128 + lkey; kp0 = P.KV() + tok * 2048 + hd * 256 + lq * 8; kp1 = P.KPE() + tok * 64 + lq * 8; }
    else { const size_t tok = (size_t)b * 2048 + (size_t)(t_begin * 128 + lkey) * dmul + r0; kp0 = P.KD() + tok * 512 + hd * 64 + lq * 8; kp1 = P.VD() + tok * 512 + hd * 64 + lq * 8; }
    const size_t kstep0 = MODE == 0 ? (size_t)128 * 2048 : (size_t)128 * dmul * 512, kstep1 = MODE == 0 ? (size_t)128 * 64 : (size_t)128 * dmul * 512;
#define ATT_LOAD() do { \
        if (MODE == 0) { _Pragma("unroll") for (int i_ = 0; i_ < 4; ++i_) { kreg[i_] = *(const u32x4*)(kp0 + i_ * 32); vreg[i_] = *(const u32x4*)(kp0 + 128 + i_ * 32); } \
                         _Pragma("unroll") for (int i_ = 0; i_ < 2; ++i_) kreg[4 + (MODE == 0 ? i_ : 0)] = *(const u32x4*)(kp1 + i_ * 32); } \
        else { _Pragma("unroll") for (int i_ = 0; i_ < 2; ++i_) { kreg[i_] = *(const u32x4*)(kp0 + i_ * 32); vreg[i_] = *(const u32x4*)(kp1 + i_ * 32); } } \
        kp0 += kstep0; kp1 += kstep1; } while (0)
    ATT_LOAD();
    const LAS unsigned char* Kw = Ks + (kh * 64 + r) * KSTR + h * 16;
    const LAS unsigned char* Vw = Vs + (kh * 64 + 4 * h + ((lane & 15) >> 2)) * VSTR + (16 * ((lane >> 4) & 1) + 4 * (lane & 3)) * 2;
    for (int t = t_begin; t < t_end; ++t) {
        __syncthreads();
        {
            LAS unsigned char* kd = Ks + lkey * KSTR + lq * 16; LAS unsigned char* vd = Vs + lkey * VSTR + lq * 16;
            if (MODE == 0) {
#pragma unroll
                for (int i = 0; i < 4; ++i) { *(LAS u32x4*)(kd + i * 64) = kreg[i]; *(LAS u32x4*)(vd + i * 64) = vreg[i]; }
#pragma unroll
                for (int i = 0; i < 2; ++i) *(LAS u32x4*)(kd + 256 + i * 64) = kreg[4 + (MODE == 0 ? i : 0)];
            } else {
#pragma unroll
                for (int i = 0; i < 2; ++i) { *(LAS u32x4*)(kd + i * 64) = kreg[i]; *(LAS u32x4*)(vd + i * 64) = vreg[i]; }
            }
        }
        __syncthreads();
        if (t + 1 < t_end) ATT_LOAD();
        f32x16 x0, x1;
#pragma unroll
        for (int i = 0; i < 16; ++i) { x0[i] = 0.f; x1[i] = 0.f; }
#pragma unroll
        for (int kk = 0; kk < NKK; ++kk) {
            const bf16x8 a0 = *(const LAS bf16x8*)(Kw + kk * 32), a1 = *(const LAS bf16x8*)(Kw + 32 * KSTR + kk * 32);
            const bf16x8 qv = MODE == 0 ? *(const LAS bf16x8*)(Qw + kk * 32) : qf[MODE == 0 ? 0 : kk];
            x0 = MFMA32(a0, qv, x0); x1 = MFMA32(a1, qv, x1);
            if ((kk & 3) == 3) __builtin_amdgcn_sched_barrier(0);
        }
        const int keyb = t * 128 + kh * 64;
        if (MODE == 1 || t == t_end - 1) {
#pragma unroll
            for (int i = 0; i < 16; ++i) {
                const int k0 = keyb + crow(i, h), k1 = k0 + 32;
                if (k0 > fq_ || (MODE == 1 && k0 + span < fq_)) x0[i] = -INFINITY;
                if (k1 > fq_ || (MODE == 1 && k1 + span < fq_)) x1[i] = -INFINITY;
            }
        }
        float mloc = fmaxf(x0[0], x1[0]);
#pragma unroll
        for (int i = 1; i < 16; ++i) mloc = fmaxf(mloc, fmaxf(x0[i], x1[i]));
        mloc = fmaxf(mloc, __shfl_xor(mloc, 32));
        const float mnew = fmaxf(mrun, mloc);
        const float msafe = mnew == -INFINITY ? 0.f : mnew;
        const float alpha = fexp2(mrun - msafe);
        float psum = 0.f;
#pragma unroll
        for (int i = 0; i < 16; ++i) { x0[i] = fexp2(x0[i] - msafe); x1[i] = fexp2(x1[i] - msafe); psum += x0[i] + x1[i]; }
        lrun = lrun * alpha + psum; mrun = mnew;
        if (__builtin_amdgcn_ballot_w64(alpha != 1.f) != 0ull) {
#pragma unroll
            for (int d = 0; d < NDV; ++d)
#pragma unroll
                for (int i = 0; i < 16; ++i) o[d][i] *= alpha;
        }
#pragma unroll
        for (int ht = 0; ht < 2; ++ht)
#pragma unroll
            for (int s = 0; s < 2; ++s) {
                const bf16x8 pf = pack_step(ht == 0 ? x0 : x1, s);
#pragma unroll
                for (int d = 0; d < NDV; ++d) {
                    const s16x4 lo = vtr(Vw + (ht * 32 + 16 * s) * VSTR + d * 64), hi = vtr(Vw + (ht * 32 + 16 * s + 8) * VSTR + d * 64);
                    const bf16x8 pa = __builtin_shufflevector(lo, hi, 0, 1, 2, 3, 4, 5, 6, 7);
                    o[d] = MFMA32(pa, pf, o[d]);
                }
                __builtin_amdgcn_sched_barrier(0);
            }
    }
#undef ATT_LOAD
    lrun += __shfl_xor(lrun, 32);
    __syncthreads();
    LAS float* MS = (LAS float*)lds + rg * ((NDV * 16 + 2) * 64);
    if (kh == 1) {
#pragma unroll
        for (int d = 0; d < NDV; ++d)
#pragma unroll
            for (int i = 0; i < 16; ++i) MS[(d * 16 + i) * 64 + lane] = o[d][i];
        MS[(NDV * 16) * 64 + lane] = mrun; MS[(NDV * 16 + 1) * 64 + lane] = lrun;
    }
    __syncthreads();
    if (kh == 0) {
        const float m1 = MS[(NDV * 16) * 64 + lane], l1 = MS[(NDV * 16 + 1) * 64 + lane];
        const float mm = fmaxf(mrun, m1), ms = mm == -INFINITY ? 0.f : mm;
        const float f0 = fexp2(mrun - ms), f1 = fexp2(m1 - ms);
        const float lt = lrun * f0 + l1 * f1, inv = 1.f / lt;
        float sq = 0.f;
#pragma unroll
        for (int d = 0; d < NDV; ++d)
#pragma unroll
            for (int g = 0; g < 4; ++g) {
                f32x4 v;
#pragma unroll
                for (int e = 0; e < 4; ++e) v[e] = (o[d][4 * g + e] * f0 + MS[(d * 16 + 4 * g + e) * 64 + lane] * f1) * inv;
                const int dv = d * 32 + 8 * g + 4 * h;
                if (MODE == 0) { u32x2 w; w.x = cvtpk(v[0], v[1]); w.y = cvtpk(v[2], v[3]); *(u32x2*)(P.YCAT() + tokq * 2048 + 512 + hd * 128 + dv) = w; sq += (v[0] * v[0] + v[1] * v[1]) + (v[2] * v[2] + v[3] * v[3]); }
                else { u32x2 w; w.x = cvtpk(v[0], v[1]); w.y = cvtpk(v[2], v[3]); *(u32x2*)(P.DP() + ((size_t)pat * M_ + tokq) * 512 + hd * 64 + dv) = w; }
            }
        if (MODE == 0) { sq += __shfl_xor(sq, 32); if (ATOM && h == 0) ss_add(P.ss_mla() + tokq, sq); }
        else { if (h == 0) P.DLSE()[((size_t)pat * M_ + tokq) * 8 + hd] = mm + __log2f(lt); }
    }
}


template <bool ATOM>
DI void mla_unit(LAS unsigned char* lds, const AttnPtrs& P, int b, int hd, int qb) {
    constexpr int KSTR = 400, VSTR = 288, NKK = 12, NDV = 4, BUFB = 64 * KSTR + 64 * VSTR;
    const int tid = opaque_tid(), lane = tid & 63, wid = __builtin_amdgcn_readfirstlane(tid >> 6), r = lane & 31, h = lane >> 5, rg = wid & 3, kh = wid >> 2;
    const int fq_ = qb * 128 + rg * 32 + r;
    const size_t tokq = (size_t)b * 2048 + fq_;
    bf16x8 qf[NKK];
    { const bf16_t* qp = P.Q() + tokq * 1536 + hd * 192;
#pragma unroll
      for (int kk = 0; kk < NKK; ++kk) qf[kk] = *(const bf16x8*)(qp + kk * 16 + 8 * h); }
    f32x16 o[NDV];
#pragma unroll
    for (int d = 0; d < NDV; ++d)
#pragma unroll
        for (int i = 0; i < 16; ++i) o[d][i] = 0.f;
    float mrun = -INFINITY, lrun = 0.f;
    const int lkey = tid >> 3, lq = tid & 7;
    const bf16_t* kp0 = P.KV() + ((size_t)b * 2048 + lkey) * 2048 + hd * 256 + lq * 8;
    const bf16_t* kp1 = P.KPE() + ((size_t)b * 2048 + lkey) * 64 + lq * 8;
    u32x4 sreg[5];
#define MLA_LOAD() do { sreg[0] = *(const u32x4*)(kp0); sreg[1] = *(const u32x4*)(kp0 + 64); sreg[2] = *(const u32x4*)(kp0 + 128); sreg[3] = *(const u32x4*)(kp0 + 192); \
        sreg[4] = *(const u32x4*)(kp1); kp0 += (size_t)64 * 2048; kp1 += (size_t)64 * 64; } while (0)
#define MLA_WRITE(buf) do { LAS unsigned char* kd_ = lds + (buf) * BUFB + lkey * KSTR + lq * 16; LAS unsigned char* vd_ = lds + (buf) * BUFB + 64 * KSTR + lkey * VSTR + lq * 16; \
        *(LAS u32x4*)(kd_) = sreg[0]; *(LAS u32x4*)(kd_ + 128) = sreg[1]; *(LAS u32x4*)(kd_ + 256) = sreg[4]; *(LAS u32x4*)(vd_) = sreg[2]; *(LAS u32x4*)(vd_ + 128) = sreg[3]; } while (0)
    const int nsteps = 2 * (qb + 1);
    __syncthreads();
    MLA_LOAD(); MLA_WRITE(0);
    MLA_LOAD();
    __syncthreads();
    if (kh == 1) __syncthreads();
    const int kwo = (kh * 32 + r) * KSTR + h * 16;
    const int vwo = 64 * KSTR + (kh * 32 + 4 * h + ((lane & 15) >> 2)) * VSTR + (16 * ((lane >> 4) & 1) + 4 * (lane & 3)) * 2;
    int bc = 0, bw = 1;
    for (int t = 0; t < nsteps; ++t) {
        if (t + 1 < nsteps) MLA_WRITE(bw);
        if (t + 2 < nsteps) MLA_LOAD();
        const int keyb = t * 64 + kh * 32;
        const bool act = keyb <= qb * 128 + rg * 32 + 31;
        f32x16 xa, xb;
#pragma unroll
        for (int i = 0; i < 16; ++i) { xa[i] = 0.f; xb[i] = 0.f; }
        if (act) {
            const LAS unsigned char* Kw = lds + bc * BUFB + kwo;
#pragma unroll
            for (int kk = 0; kk < NKK; kk += 2) {
                const bf16x8 a0 = *(const LAS bf16x8*)(Kw + kk * 32), a1 = *(const LAS bf16x8*)(Kw + kk * 32 + 32);
                xa = MFMA32(a0, qf[kk], xa); xb = MFMA32(a1, qf[kk + 1], xb);
                if ((kk & 3) == 2) __builtin_amdgcn_sched_barrier(0);
            }
        }
        __syncthreads();
        if (act) {
            const LAS unsigned char* Vw = lds + bc * BUFB + vwo;
            f32x16 x0;
#pragma unroll
            for (int i = 0; i < 16; ++i) x0[i] = xa[i] + xb[i];
            if (keyb + 31 > qb * 128 + rg * 32) {
#pragma unroll
                for (int i = 0; i < 16; ++i) if (keyb + crow(i, h) > fq_) x0[i] = -INFINITY;
            }
            float mloc = x0[0];
#pragma unroll
            for (int i = 1; i < 16; ++i) mloc = fmaxf(mloc, x0[i]);
            mloc = fmaxf(mloc, __shfl_xor(mloc, 32));
            const float mnew = fmaxf(mrun, mloc);
            const float msafe = mnew == -INFINITY ? 0.f : mnew;
            const float alpha = fexp2(mrun - msafe);
            float psum = 0.f;
#pragma unroll
            for (int i = 0; i < 16; ++i) { x0[i] = fexp2(x0[i] - msafe); psum += x0[i]; }
            lrun = lrun * alpha + psum; mrun = mnew;
            if (__builtin_amdgcn_ballot_w64(alpha != 1.f) != 0ull) {
#pragma unroll
                for (int d = 0; d < NDV; ++d)
#pragma unroll
                    for (int i = 0; i < 16; ++i) o[d][i] *= alpha;
            }
#pragma unroll
            for (int s2 = 0; s2 < 2; ++s2) {
                const bf16x8 pf = pack_step(x0, s2);
#pragma unroll
                for (int d = 0; d < NDV; ++d) {
                    const s16x4 lo = vtr(Vw + (16 * s2) * VSTR + d * 64), hi = vtr(Vw + (16 * s2 + 8) * VSTR + d * 64);
                    const bf16x8 pa = __builtin_shufflevector(lo, hi, 0, 1, 2, 3, 4, 5, 6, 7);
                    o[d] = MFMA32(pa, pf, o[d]);
                }
                __builtin_amdgcn_sched_barrier(0);
            }
        }
        __syncthreads();
        bc = bw; bw = bw == 2 ? 0 : bw + 1;
    }
    if (kh == 0) __syncthreads();
#undef MLA_LOAD
#undef MLA_WRITE
    lrun += __shfl_xor(lrun, 32);
    LAS float* MS = (LAS float*)lds + rg * ((NDV * 16 + 2) * 64);
    if (kh == 1) {
#pragma unroll
        for (int d = 0; d < NDV; ++d)
#pragma unroll
            for (int i = 0; i < 16; ++i) MS[(d * 16 + i) * 64 + lane] = o[d][i];
        MS[(NDV * 16) * 64 + lane] = mrun; MS[(NDV * 16 + 1) * 64 + lane] = lrun;
    }
    __syncthreads();
    if (kh == 0) {
        const float m1 = MS[(NDV * 16) * 64 + lane], l1 = MS[(NDV * 16 + 1) * 64 + lane];
        const float mm = fmaxf(mrun, m1), ms = mm == -INFINITY ? 0.f : mm;
        const float f0 = fexp2(mrun - ms), f1 = fexp2(m1 - ms);
        const float lt = lrun * f0 + l1 * f1, inv = 1.f / lt;
        float sq = 0.f;
#pragma unroll
        for (int d = 0; d < NDV; ++d)
#pragma unroll
            for (int g = 0; g < 4; ++g) {
                f32x4 v;
#pragma unroll
                for (int e = 0; e < 4; ++e) v[e] = (o[d][4 * g + e] * f0 + MS[(d * 16 + 4 * g + e) * 64 + lane] * f1) * inv;
                const int dv = d * 32 + 8 * g + 4 * h;
                u32x2 w; w.x = cvtpk(v[0], v[1]); w.y = cvtpk(v[2], v[3]); *(u32x2*)(P.YCAT() + tokq * 2048 + 512 + hd * 128 + dv) = w; sq += (v[0] * v[0] + v[1] * v[1]) + (v[2] * v[2] + v[3] * v[3]);
            }
        sq += __shfl_xor(sq, 32); if (ATOM && h == 0) ss_add(P.ss_mla() + tokq, sq);
    }
}

DI void ssm_s1(PP p, LAS unsigned char* lds, int l) {
    const int tid = opaque_tid(), lane = tid & 63, wid = __builtin_amdgcn_readfirstlane(tid >> 6);
    unsigned char* ws = p->ws;
#define WSF(off) ((float*)(ws + (unsigned)(off)))
#define U WSF(WS_U)
#define ABAR WSF(WS_ABAR)
#define A64 WSF(WS_A64)
#define BB WSF(WS_BB)
#define CT WSF(WS_CT)
#define SST WSF(WS_SST)
    LAS float* US = (LAS float*)(lds + wid * 16384);
    for (int it = blockIdx.x * 8 + wid; it < 4 * 32 * 32; it += gridDim.x * 8) {
        const int g = it & 31, c = (it >> 5) & 31, b = it >> 10, lg = l * 32 + g;
        const size_t tok0 = (size_t)b * 2048 + c * 64;
        { const f32x4* up = (const f32x4*)(U + (tok0 + lane) * 512 + g * 16);
#pragma unroll
          for (int j = 0; j < 4; ++j) *(LAS f32x4*)(US + lane * 16 + 4 * j) = up[j]; }
        const float are = ABAR[(lg * 64 + lane) * 2], aim = ABAR[(lg * 64 + lane) * 2 + 1];
        f32x2 bb[16];
        { const f32x4* bp = (const f32x4*)(BB + ((size_t)(lg * 64 + lane) * 16) * 2);
#pragma unroll
          for (int j = 0; j < 8; ++j) { const f32x4 v = bp[j]; bb[2 * j] = (f32x2){v[0], v[1]}; bb[2 * j + 1] = (f32x2){v[2], v[3]}; } }
        asm volatile("s_waitcnt lgkmcnt(0)" ::: "memory");
        f32x2 hh = {0.f, 0.f}; const f32x2 a1 = {are, are}, a2 = {-aim, aim};
        for (int t = 0; t < 64; ++t) {
            f32x2 uu = {0.f, 0.f};
#pragma unroll
            for (int j = 0; j < 4; ++j) { const f32x4 uv = *(const LAS f32x4*)(US + t * 16 + 4 * j);
#pragma unroll
                for (int e = 0; e < 4; ++e) uu += bb[4 * j + e] * uv[e]; }
            hh = a1 * hh + a2 * (f32x2){hh[1], hh[0]} + uu;
        }
        *(f32x2*)(SST + ((size_t)((b * 32 + c) * 32 + g) * 64 + lane) * 2) = hh;
        asm volatile("s_waitcnt lgkmcnt(0)" ::: "memory");
    }
}
DI void ssm_s3(PP p, LAS unsigned char* lds, int l) {
    const int tid = opaque_tid(), lane = tid & 63, wid = __builtin_amdgcn_readfirstlane(tid >> 6);
    unsigned char* ws = p->ws;
    const float* dskip = p->in[13] + l * 512; bf16_t* YG = (bf16_t*)(ws + (unsigned)WS_YG);
    LAS float* US = (LAS float*)(lds + wid * 16384);
    LAS float* HS = US + 1024;
    for (int it = blockIdx.x * 8 + wid; it < 4 * 32 * 32; it += gridDim.x * 8) {
        const int g = it & 31, c = (it >> 5) & 31, b = it >> 10, lg = l * 32 + g;
        const size_t tok0 = (size_t)b * 2048 + c * 64;
        { const f32x4* up = (const f32x4*)(U + (tok0 + lane) * 512 + g * 16);
#pragma unroll
          for (int j = 0; j < 4; ++j) *(LAS f32x4*)(US + lane * 16 + 4 * j) = up[j]; }
        const float are = ABAR[(lg * 64 + lane) * 2], aim = ABAR[(lg * 64 + lane) * 2 + 1];
        const float a6re = A64[(lg * 64 + lane) * 2], a6im = A64[(lg * 64 + lane) * 2 + 1];
        f32x2 bb[16];
        { const f32x4* bp = (const f32x4*)(BB + ((size_t)(lg * 64 + lane) * 16) * 2);
#pragma unroll
          for (int j = 0; j < 8; ++j) { const f32x4 v = bp[j]; bb[2 * j] = (f32x2){v[0], v[1]}; bb[2 * j + 1] = (f32x2){v[2], v[3]}; } }
        float cc[32];
        { const f32x4* cp = (const f32x4*)(CT + ((size_t)(lg * 4 + (lane >> 4)) * 16 + (lane & 15)) * 32);
#pragma unroll
          for (int j = 0; j < 8; ++j) { const f32x4 v = cp[j]; cc[4 * j] = v[0]; cc[4 * j + 1] = v[1]; cc[4 * j + 2] = v[2]; cc[4 * j + 3] = v[3]; } }
        const float dsk = dskip[g * 16 + (lane & 15)];
        f32x2 hh = {0.f, 0.f}; const f32x2 a1 = {are, are}, a2 = {-aim, aim};
        { const f32x2* sp = (const f32x2*)SST + (size_t)(b * 32 * 32 + g) * 64 + lane;
          const f32x2 c1 = {a6re, a6re}, c2 = {-a6im, a6im};
          f32x2 sv[31];
#pragma unroll
          for (int cp_ = 0; cp_ < 31; ++cp_) sv[cp_] = cp_ < c ? sp[(size_t)cp_ * 32 * 64] : (f32x2){0.f, 0.f};
#pragma unroll
          for (int cp_ = 0; cp_ < 31; ++cp_) if (cp_ < c) hh = c1 * hh + c2 * (f32x2){hh[1], hh[0]} + sv[cp_]; }
        asm volatile("s_waitcnt lgkmcnt(0)" ::: "memory");
        for (int sc = 0; sc < 4; ++sc) {
            for (int t16 = 0; t16 < 16; ++t16) {
                const int t = sc * 16 + t16;
                f32x2 uu = {0.f, 0.f};
#pragma unroll
                for (int j = 0; j < 4; ++j) { const f32x4 uv = *(const LAS f32x4*)(US + t * 16 + 4 * j);
#pragma unroll
                    for (int e = 0; e < 4; ++e) uu += bb[4 * j + e] * uv[e]; }
                hh = a1 * hh + a2 * (f32x2){hh[1], hh[0]} + uu;
                HS[t16 * 132 + lane] = hh[0]; HS[t16 * 132 + 64 + lane] = hh[1];
            }
            asm volatile("s_waitcnt lgkmcnt(0)" ::: "memory");
            f32x4 acc = {0.f, 0.f, 0.f, 0.f};
            const LAS float* hp = HS + (lane & 15) * 132 + 32 * (lane >> 4);
#pragma unroll
            for (int j = 0; j < 8; ++j) { const f32x4 hv = *(const LAS f32x4*)(hp + 4 * j);
#pragma unroll
                for (int e = 0; e < 4; ++e) acc = __builtin_amdgcn_mfma_f32_16x16x4f32(hv[e], cc[4 * j + e], acc, 0, 0, 0); }
#pragma unroll
            for (int j = 0; j < 4; ++j) {
                const int t = sc * 16 + 4 * (lane >> 4) + j;
                float y = acc[j] + dsk * US[t * 16 + (lane & 15)];
                const float z = 0.7978845608028654f * (y + 0.044715f * y * y * y);
                const float th = 1.f - 2.f * __builtin_amdgcn_rcpf(1.f + fexp2(2.f * LOG2E * z));
                y = 0.5f * y * (1.f + th);
                YG[(tok0 + t) * 512 + g * 16 + (lane & 15)] = (bf16_t)(cvtpk(y, 0.f) & 0xffffu);
            }
            asm volatile("s_waitcnt lgkmcnt(0)" ::: "memory");
        }
    }
}

#undef U
#undef ABAR
#undef A64
#undef BB
#undef CT
#undef SST
#undef WSF
#undef U
#undef ABAR
#undef A64
#undef SST
#define MFMA16(a, b, c) __builtin_amdgcn_mfma_f32_16x16x32_bf16((a), (b), (c), 0, 0, 0)
constexpr int SSM_WREG = 16384;
#define WSF(off) ((float*)(ws + (unsigned)(off)))
#define U WSF(WS_U)
#define ABAR WSF(WS_ABAR)
#define A64 WSF(WS_A64)
#define SST WSF(WS_SST)
DI void ssm_load_u(const float* Up, LAS unsigned char* UB, int lane) {
    const f32x4* up = (const f32x4*)Up;
    const f32x4 a = up[0], b = up[1], c = up[2], d = up[3];
    *(LAS u32x4*)(UB + lane * 32) = pack8(a, b); *(LAS u32x4*)(UB + lane * 32 + 16) = pack8(c, d);
    if (lane < 2) *(LAS u32x4*)(UB + 64 * 32 + lane * 16) = (u32x4){0u, 0u, 0u, 0u};
}
DI void ssm_bu16(const LAS unsigned char* UB, LAS float* BUS, const bf16x8 (&bfr)[8], int sc, int lane) {
    const bf16x8 af = *(const LAS bf16x8*)(UB + (lane < 32 ? (sc * 16 + (lane & 15)) * 32 + (lane >> 4) * 16 : 64 * 32));
    f32x4 acc[8];
    asm volatile("s_nop 15" :: "v"(af));
#pragma unroll
    for (int j = 0; j < 8; ++j) acc[j] = MFMA16(af, bfr[j], ((f32x4){0.f, 0.f, 0.f, 0.f}));
    asm volatile("s_nop 15\n\ts_nop 15\n\ts_nop 15\n\ts_nop 15" : "+v"(acc[0]), "+v"(acc[1]), "+v"(acc[2]), "+v"(acc[3]), "+v"(acc[4]), "+v"(acc[5]), "+v"(acc[6]), "+v"(acc[7]) : "v"(af));
#pragma unroll
    for (int j = 0; j < 8; ++j)
#pragma unroll
        for (int e = 0; e < 4; ++e) BUS[(4 * (lane >> 4) + e) * 132 + 16 * j + (lane & 15)] = acc[j][e];
}
DI void ssm_load_bfr(const bf16_t* BBb, int lg, int lane, bf16x8 (&bfr)[8]) {
#pragma unroll
    for (int j = 0; j < 8; ++j) bfr[j] = *(const bf16x8*)(BBb + ((size_t)lg * 128 + 16 * j + (lane & 15)) * 16 + 8 * ((lane >> 4) & 1));
}
DI void ssm_s1_m(PP p, LAS unsigned char* lds, int l) {
    const int tid = opaque_tid(), lane = tid & 63, wid = __builtin_amdgcn_readfirstlane(tid >> 6);
    unsigned char* ws = p->ws;
    LAS unsigned char* UB = lds + wid * SSM_WREG; LAS float* BUS = (LAS float*)(UB + 2176);
    for (int it = blockIdx.x * 8 + wid; it < 4 * 32 * 32; it += gridDim.x * 8) {
        const int g = it & 31, c = (it >> 5) & 31, b = it >> 10, lg = l * 32 + g;
        const size_t tok0 = (size_t)b * 2048 + c * 64;
        ssm_load_u(U + (tok0 + lane) * 512 + g * 16, UB, lane);
        const float are = ABAR[(lg * 64 + lane) * 2], aim = ABAR[(lg * 64 + lane) * 2 + 1];
        bf16x8 bfr[8]; ssm_load_bfr((const bf16_t*)(ws + (unsigned)WS_BBB), lg, lane, bfr);
        asm volatile("s_waitcnt lgkmcnt(0)" ::: "memory");
        f32x2 hh = {0.f, 0.f}; const f32x2 a1 = {are, are}, a2 = {-aim, aim};
        for (int sc = 0; sc < 4; ++sc) {
            ssm_bu16(UB, BUS, bfr, sc, lane);
            asm volatile("s_waitcnt lgkmcnt(0)" ::: "memory");
#pragma unroll 4
            for (int t16 = 0; t16 < 16; ++t16) { const f32x2 bu = *(const LAS f32x2*)(BUS + t16 * 132 + 2 * lane); hh = a1 * hh + a2 * (f32x2){hh[1], hh[0]} + bu; }
            asm volatile("s_waitcnt lgkmcnt(0)" ::: "memory");
        }
        *(f32x2*)(SST + ((size_t)((b * 32 + c) * 32 + g) * 64 + lane) * 2) = hh;
    }
}
DI void ssm_s3_m(PP p, LAS unsigned char* lds, int l) {
    const int tid = opaque_tid(), lane = tid & 63, wid = __builtin_amdgcn_readfirstlane(tid >> 6);
    unsigned char* ws = p->ws;
    const float* dskip = p->in[13] + l * 512; bf16_t* YG = (bf16_t*)(ws + (unsigned)WS_YG);
    LAS unsigned char* UB = lds + wid * SSM_WREG; LAS float* BUS = (LAS float*)(UB + 2176); LAS unsigned char* HB = (LAS unsigned char*)(BUS + 16 * 132);
    for (int it = blockIdx.x * 8 + wid; it < 4 * 32 * 32; it += gridDim.x * 8) {
        const int g = it & 31, c = (it >> 5) & 31, b = it >> 10, lg = l * 32 + g;
        const size_t tok0 = (size_t)b * 2048 + c * 64;
        ssm_load_u(U + (tok0 + lane) * 512 + g * 16, UB, lane);
        const float are = ABAR[(lg * 64 + lane) * 2], aim = ABAR[(lg * 64 + lane) * 2 + 1];
        const float a6re = A64[(lg * 64 + lane) * 2], a6im = A64[(lg * 64 + lane) * 2 + 1];
        bf16x8 bfr[8]; ssm_load_bfr((const bf16_t*)(ws + (unsigned)WS_BBB), lg, lane, bfr);
        bf16x8 cfr[4];
#pragma unroll
        for (int kk = 0; kk < 4; ++kk) cfr[kk] = *(const bf16x8*)((const bf16_t*)(ws + (unsigned)WS_CTB) + ((size_t)lg * 16 + (lane & 15)) * 128 + 32 * kk + 8 * (lane >> 4));
        const float dsk = dskip[g * 16 + (lane & 15)];
        f32x2 hh = {0.f, 0.f}; const f32x2 a1 = {are, are}, a2 = {-aim, aim};
        { const f32x2* sp = (const f32x2*)SST + (size_t)(b * 32 * 32 + g) * 64 + lane;
          const f32x2 c1 = {a6re, a6re}, c2 = {-a6im, a6im};
          f32x2 sv[31];
#pragma unroll
          for (int cp_ = 0; cp_ < 31; ++cp_) sv[cp_] = cp_ < c ? sp[(size_t)cp_ * 32 * 64] : (f32x2){0.f, 0.f};
#pragma unroll
          for (int cp_ = 0; cp_ < 31; ++cp_) if (cp_ < c) hh = c1 * hh + c2 * (f32x2){hh[1], hh[0]} + sv[cp_]; }
        asm volatile("s_waitcnt lgkmcnt(0)" ::: "memory");
        for (int sc = 0; sc < 4; ++sc) {
            ssm_bu16(UB, BUS, bfr, sc, lane);
            asm volatile("s_waitcnt lgkmcnt(0)" ::: "memory");
#pragma unroll 4
            for (int t16 = 0; t16 < 16; ++t16) {
                const f32x2 bu = *(const LAS f32x2*)(BUS + t16 * 132 + 2 * lane);
                hh = a1 * hh + a2 * (f32x2){hh[1], hh[0]} + bu;
                *(LAS unsigned*)(HB + t16 * 272 + 4 * lane) = cvtpk(hh[0], hh[1]);
            }
            asm volatile("s_waitcnt lgkmcnt(0)" ::: "memory");
            f32x4 acc = {0.f, 0.f, 0.f, 0.f};
            bf16x8 hf[4];
#pragma unroll
            for (int kk = 0; kk < 4; ++kk) hf[kk] = *(const LAS bf16x8*)(HB + (lane & 15) * 272 + (32 * kk + 8 * (lane >> 4)) * 2);
            asm volatile("s_waitcnt lgkmcnt(0)\n\ts_nop 15" : "+v"(hf[0]), "+v"(hf[1]), "+v"(hf[2]), "+v"(hf[3]) :: "memory");
#pragma unroll
            for (int kk = 0; kk < 4; ++kk) acc = MFMA16(hf[kk], cfr[kk], acc);
            asm volatile("s_nop 15\n\ts_nop 15\n\ts_nop 15\n\ts_nop 15" : "+v"(acc) : "v"(hf[0]), "v"(hf[1]), "v"(hf[2]), "v"(hf[3]));
#pragma unroll
            for (int j = 0; j < 4; ++j) {
                const int t = sc * 16 + 4 * (lane >> 4) + j;
                float y = acc[j] + dsk * bf2f(*(const LAS bf16_t*)(UB + t * 32 + (lane & 15) * 2));
                const float z = 0.7978845608028654f * (y + 0.044715f * y * y * y);
                const float th = 1.f - 2.f * __builtin_amdgcn_rcpf(1.f + fexp2(2.f * LOG2E * z));
                y = 0.5f * y * (1.f + th);
                YG[(tok0 + t) * 512 + g * 16 + (lane & 15)] = (bf16_t)(cvtpk(y, 0.f) & 0xffffu);
            }
            asm volatile("s_waitcnt lgkmcnt(0)" ::: "memory");
        }
    }
}
#undef MFMA16
#undef WSF
#undef U
#undef ABAR
#undef A64
#undef SST
DI void dil_combine(PP p, int l, int wblk, int nblk) {
    const int tid = opaque_tid(), lane = tid & 63, wid = __builtin_amdgcn_readfirstlane(tid >> 6);
    unsigned char* ws = p->ws;
    const bf16_t* DP = (const bf16_t*)(ws + WS_DP); const float* DLSE = (const float*)(ws + WS_DLSE); bf16_t* YCAT = (bf16_t*)(ws + WS_YCAT);
    ssacc_t* ssd = (ssacc_t*)(ws + WS_SS) + (size_t)(SS_DIL + l) * M_;
    for (int m = wblk * 8 + wid; m < M_; m += nblk * 8) {
        const int hd = lane >> 3;
        const float l0 = DLSE[((size_t)0 * M_ + m) * 8 + hd], l1 = DLSE[((size_t)1 * M_ + m) * 8 + hd], l2 = DLSE[((size_t)2 * M_ + m) * 8 + hd];
        const float mx = fmaxf(l0, fmaxf(l1, l2));
        float w0 = fexp2(l0 - mx), w1 = fexp2(l1 - mx), w2 = fexp2(l2 - mx); const float inv = 1.f / (w0 + w1 + w2); w0 *= inv; w1 *= inv; w2 *= inv;
        const u32x4 q0 = *(const u32x4*)(DP + ((size_t)0 * M_ + m) * 512 + lane * 8), q1 = *(const u32x4*)(DP + ((size_t)1 * M_ + m) * 512 + lane * 8), q2 = *(const u32x4*)(DP + ((size_t)2 * M_ + m) * 512 + lane * 8);
        f32x4 a, bq;
#pragma unroll
        for (int e = 0; e < 4; ++e) {
            const unsigned u0 = q0[e], u1 = q1[e], u2 = q2[e];
            const float lo = __builtin_bit_cast(float, u0 << 16) * w0 + __builtin_bit_cast(float, u1 << 16) * w1 + __builtin_bit_cast(float, u2 << 16) * w2;
            const float hi = __builtin_bit_cast(float, u0 & 0xffff0000u) * w0 + __builtin_bit_cast(float, u1 & 0xffff0000u) * w1 + __builtin_bit_cast(float, u2 & 0xffff0000u) * w2;
            if (e < 2) { a[2 * e] = lo; a[2 * e + 1] = hi; } else { bq[2 * (e - 2)] = lo; bq[2 * (e - 2) + 1] = hi; }
        }
        *(u32x4*)(YCAT + (size_t)m * 2048 + 1536 + lane * 8) = pack8(a, bq);
        const float s = wave_sum(sq8(a, bq)); if (lane == 0) ss_set(ssd + m, s);
    }
}

DI void final_norm(PP p) {
    const int tid = opaque_tid(), lane = tid & 63, wid = __builtin_amdgcn_readfirstlane(tid >> 6);
    const float* X = (const float*)(p->ws + WS_X); const ssacc_t* ss = (const ssacc_t*)(p->ws + WS_SS) + (size_t)(SS_X + 4) * M_; const float* g = p->in[25];
    for (int m = blockIdx.x * 8 + wid; m < M_; m += gridDim.x * 8) {
        const float rs = rsqrtf(ss_get(ss + m) * (1.f / 2048.f) + EPS_);
#pragma unroll
        for (int j = 0; j < 8; ++j) { const int c = j * 256 + lane * 4; const f32x4 v = *(const f32x4*)(X + (size_t)m * 2048 + c), gg = *(const f32x4*)(g + c); *(f32x4*)(p->out + (size_t)m * 2048 + c) = v * rs * gg; }
    }
}


#define XB_TMO      128
#define XB_XCNT(j)  (256  + 64 * (j))
#define XB_XSUB(j)  (1280 + 64 * (j))
#define XB_XGEN(j)  (2304 + 64 * (j))
#define XB_TOP      3328
#define XB_TOPGEN   3392
#define XCD_BAR_WORDS 3456
#define XB_SPIN_CAP (1u << 22)
DI unsigned xb_ld(unsigned* p)              { return __hip_atomic_load(p, __ATOMIC_RELAXED, __HIP_MEMORY_SCOPE_AGENT); }
DI unsigned xb_add(unsigned* p, unsigned v) { return __hip_atomic_fetch_add(p, v, __ATOMIC_RELAXED, __HIP_MEMORY_SCOPE_AGENT); }
DI unsigned xb_xcc_id() { return (unsigned)__builtin_amdgcn_s_getreg((3 << 11) | 20) & 0xFu; }
#define XB_SPIN(cond, bar) do { unsigned _sp = 0; while (cond) { __builtin_amdgcn_s_sleep(1); \
    if ((++_sp & 255u) == 0u) { if (xb_ld(&(bar)[XB_TMO])) break; if (_sp > XB_SPIN_CAP) { atomicAdd(&(bar)[XB_TMO], 1u); break; } } } } while (0)
struct XcdBarrier { unsigned* bar; unsigned x; volatile LAS unsigned* st; };
DI XcdBarrier xcd_barrier_post(unsigned* bar, volatile LAS unsigned* st) {
    XcdBarrier b; b.bar = bar; b.x = xb_xcc_id(); b.st = st;
    if (threadIdx.x == 0) (void)xb_add(&bar[XB_XCNT(b.x)], 1u);
    return b;
}
DI void xcd_barrier_complete(unsigned* bar, unsigned x, unsigned& nloc, unsigned& nx) {
    const unsigned G = gridDim.x * gridDim.y * gridDim.z;
    unsigned sum, cnt, mine, sp = 0u;
    for (;;) {
        sum = 0u; cnt = 0u; mine = 0u;
#pragma unroll
        for (unsigned j = 0; j < 16; ++j) { const unsigned c = xb_ld(&bar[XB_XCNT(j)]); sum += c; cnt += (c > 0u) ? 1u : 0u; mine = (j == x) ? c : mine; }
        if (sum == G) break;
        __builtin_amdgcn_s_sleep(1);
        if ((++sp & 255u) == 0u) { if (xb_ld(&bar[XB_TMO])) break; if (sp > XB_SPIN_CAP) { atomicAdd(&bar[XB_TMO], 1u); break; } }
    }
    nloc = mine > 0u ? mine : 1u; nx = cnt > 0u ? cnt : 1u;
}
DI void xcd_barrier(const XcdBarrier& b) {
    asm volatile("s_waitcnt vmcnt(0)" ::: "memory");
    __syncthreads();
    if (threadIdx.x == 0) {
        unsigned* bar = b.bar;
        __builtin_amdgcn_s_waitcnt(0);
        unsigned nloc = b.st[0], nx = b.st[1];
        if (nloc == 0u) { xcd_barrier_complete(bar, b.x, nloc, nx); b.st[0] = nloc; b.st[1] = nx; }
        const unsigned old = xb_add(&bar[XB_XSUB(b.x)], 1u);
        const unsigned gen = old / nloc;
        if (old + 1u == (gen + 1u) * nloc) {
            __builtin_amdgcn_fence(__ATOMIC_RELEASE, "agent");
            asm volatile("s_waitcnt vmcnt(0)" ::: "memory");
            const unsigned og = xb_add(&bar[XB_TOP], 1u);
            const unsigned tg = og / nx;
            if (og + 1u == (tg + 1u) * nx) xb_add(&bar[XB_TOPGEN], 1u);
            else XB_SPIN(xb_ld(&bar[XB_TOPGEN]) == tg, bar);
            __builtin_amdgcn_fence(__ATOMIC_ACQUIRE, "agent");
            xb_add(&bar[XB_XGEN(b.x)], 1u);
            asm volatile("s_waitcnt vmcnt(0)" ::: "memory");
        } else {
            XB_SPIN(xb_ld(&bar[XB_XGEN(b.x)]) == gen, bar);
            __builtin_amdgcn_fence(__ATOMIC_ACQUIRE, "agent");
            asm volatile("s_waitcnt vmcnt(0)" ::: "memory");
        }
    }
    __syncthreads();
}
__global__ void __launch_bounds__(512, 2) hymba_fwd(Params p_unused) {
    extern __shared__ __attribute__((aligned(16))) unsigned char lds_raw[];
    LAS unsigned char* lds = (LAS unsigned char*)lds_raw;
    cg::grid_group grid = cg::this_grid();
#define SSP(ws, idx, l) ((ssacc_t*)((ws) + WS_SS) + (size_t)((idx) + (l)) * M_)
    volatile LAS unsigned* bst = (volatile LAS unsigned*)(lds + LDS_BYTES - 256);
    if (threadIdx.x < 2) bst[threadIdx.x] = 0u;
    __syncthreads();
    XcdBarrier xbar = xcd_barrier_post((unsigned*)(getpp()->ws + WS_CTL), bst);
#define GRID_SYNC() xcd_barrier(xbar)
#define TAIL_CONVERT(NWG, HALF) do { if (l + 1 < DEPTH_) { const int G_ = (int)gridDim.x, rem_ = (NWG) % G_; const int first_ = rem_ == 0 ? 0 : rem_, nb_ = G_ - first_; \
        if ((int)blockIdx.x >= first_) convert_weights(getpp(), lds, l + 1, (((int)blockIdx.x - first_) * 8 + (int)(threadIdx.x >> 6)) * 2 + (HALF), nb_ * 8 * 2); } } while (0)
#if !defined(NO_PRO)
    prologue(getpp(), lds);
    convert_weights(getpp(), lds, 0, blockIdx.x * 8 + (threadIdx.x >> 6), gridDim.x * 8);
#endif
    grid.sync();

    for (int l = 0; l < DEPTH_; ++l) {
#if GEMM_MASK & 1
        { PP p = getpp(); unsigned char* ws = p->ws; const unsigned char* wl = ws + WS_W + (size_t)l * W_LAYER;
          EpiInProj E{ws, l};
          run_gemm(lds, (const bf16_t*)(ws + WS_XB), (const bf16_t*)(wl + W_IN), NIN_, 2048, E); }
#endif
        TAIL_CONVERT(384, 0);
        GRID_SYNC();
#if GEMM_MASK & 2
        { PP p = getpp(); unsigned char* ws = p->ws; const unsigned char* wl = ws + WS_W + (size_t)l * W_LAYER;
          EpiQUp E{SSP(ws, SS_Q, l), (const float*)(ws + WS_ROPE), (bf16_t*)(ws + WS_Q)}; for (int rep = 0; rep < ((DUP_GEMM & 1) ? 2 : 1); ++rep) run_gemm(lds, (const bf16_t*)(ws + WS_CQ), (const bf16_t*)(wl + W_UQ), 1536, 512, E); }
#endif
#if GEMM_MASK & 4
        { PP p = getpp(); unsigned char* ws = p->ws; const unsigned char* wl = ws + WS_W + (size_t)l * W_LAYER;
          EpiKvUp E{SSP(ws, SS_KV, l), (bf16_t*)(ws + WS_KV)}; for (int rep = 0; rep < ((DUP_GEMM & 1) ? 2 : 1); ++rep) run_gemm(lds, (const bf16_t*)(ws + WS_CKV), (const bf16_t*)(wl + W_UKV), 2048, 256, E); }
#endif
        { PP p = getpp(); unsigned char* ws = p->ws;
          AttnPtrs AP{ws, l};
          for (int it = blockIdx.x; it < 1536; it += gridDim.x) {
              const int pat = it >> 9, b = (it >> 7) & 3, hd = (it >> 4) & 7, x = it & 15;
              const int dmul = pat == 0 ? 1 : (pat == 1 ? 4 : 16), nper = 16 / dmul, r0 = x / nper, nbk = x % nper;
#if !defined(NO_ATT1)
              attn_unit<1>(lds, AP, b, hd, nbk * 128, dmul, r0, pat, nbk > 0 ? nbk - 1 : 0, nbk + 1);
              if (DUP_MIX & 1) attn_unit<1>(lds, AP, b, hd, nbk * 128, dmul, r0, pat, nbk > 0 ? nbk - 1 : 0, nbk + 1);
#endif
          }
          __syncthreads(); }
#if !defined(NO_SSM)
        ssm_s1_m(getpp(), lds, l);
        if (DUP_MIX & 2) ssm_s1(getpp(), lds, l);
#endif
        GRID_SYNC();
#if !defined(NO_SSM)
        ssm_s3_m(getpp(), lds, l);
        if (DUP_MIX & 8) ssm_s3(getpp(), lds, l);
#endif
        __syncthreads();
        { PP p = getpp(); unsigned char* ws = p->ws;
          AttnPtrs AP{ws, l};
          LAS int* tk = (LAS int*)(lds + LDS_BYTES - 128);
          if (threadIdx.x == 0) {
              unsigned* ctl = (unsigned*)(ws + WS_CTL); int pr0 = -1;
              if (gridDim.x == 256) { bool uni = true;
                  for (int jx = 0; jx < 16; ++jx) uni = uni && (xb_ld(&ctl[XB_XCNT(jx)]) == (jx < 8 ? 32u : 0u));
                  if (uni) { const unsigned xcc = xb_xcc_id(); const unsigned tkt = xb_add(&ctl[8192 + l * 16 + xcc], 1u); if (xcc < 8 && tkt < 32) pr0 = (int)((xcc * 4 + (tkt >> 3)) * 8 + (tkt & 7)); } }
              *tk = pr0;
          }
          __syncthreads();
          const int prx = *tk;
          for (int pr = blockIdx.x; pr < 256; pr += gridDim.x) {
              const int pq = prx >= 0 ? prx : pr;
              const int bh = pq >> 3, j = pq & 7, b = bh >> 3, hd = bh & 7;
#if !defined(NO_ATT0)
              mla_unit<true>(lds, AP, b, hd, j);
              mla_unit<true>(lds, AP, b, hd, 15 - j);
              if (DUP_MIX & 16) { mla_unit<false>(lds, AP, b, hd, j); mla_unit<false>(lds, AP, b, hd, 15 - j); }
#endif
          }
          __syncthreads(); }
        GRID_SYNC();
#if GEMM_MASK & 8
        { PP p = getpp(); unsigned char* ws = p->ws; const unsigned char* wl = ws + WS_W + (size_t)l * W_LAYER;
          EpiGlu E{p->in[16] + l * 1024, (bf16_t*)(ws + WS_YCAT), SSP(ws, SS_SSM, l)}; run_gemm(lds, (const bf16_t*)(ws + WS_YG), (const bf16_t*)(wl + W_GLU), 1024, 512, E); }
#endif
        { const int G_ = (int)gridDim.x, first_ = G_ > 128 ? 128 : 0; if ((int)blockIdx.x >= first_) dil_combine(getpp(), l, (int)blockIdx.x - first_, G_ - first_); }
        GRID_SYNC();
#if GEMM_MASK & 16
        { PP p = getpp(); unsigned char* ws = p->ws; const unsigned char* wl = ws + WS_W + (size_t)l * W_LAYER;
          const ssacc_t *ss_ssm = SSP(ws, SS_SSM, l), *ss_mla = SSP(ws, SS_MLA, l), *ss_dil = SSP(ws, SS_DIL, l);
          LAS float* FT = (LAS float*)(lds + 131072);
          { pg8::StaticOrder S; S.init(M_, 2048, (int)gridDim.x, (int)blockIdx.x);
            const int ui = threadIdx.x >> 8, rr = threadIdx.x & 255; Unit u;
            if (S.next(ui, u)) { const int row = u.pm * 256 + rr; const float rm = rsqrtf(ss_get(ss_mla + row) * (1.f / 1024.f) + EPS_), rsm = rsqrtf(ss_get(ss_ssm + row) * (1.f / 512.f) + EPS_), rd = rsqrtf(ss_get(ss_dil + row) * (1.f / 512.f) + EPS_);
                FT[(ui * 2 + 0) * 256 + rr] = rsm / rm; FT[(ui * 2 + 1) * 256 + rr] = rm / rd; }
            __syncthreads(); }
          float* X = (float*)(ws + WS_X);
          EpiWo E{ws, l, l == 0 ? p->in[0] : X, FT}; run_gemm(lds, (const bf16_t*)(ws + WS_YCAT), (const bf16_t*)(wl + W_O), 2048, 2048, E); }
#endif
        GRID_SYNC();
#if GEMM_MASK & 32
        { PP p = getpp(); unsigned char* ws = p->ws; const unsigned char* wl = ws + WS_W + (size_t)l * W_LAYER;
          EpiGateUp E{SSP(ws, SS_X1, l), (bf16_t*)(ws + WS_HM)}; for (int rep = 0; rep < ((DUP_GEMM & 2) ? 2 : 1); ++rep) run_gemm(lds, (const bf16_t*)(ws + WS_XB), (const bf16_t*)(wl + W_GU), 2 * DFF_, 2048, E); }
#endif
        TAIL_CONVERT(1408, 1);
        GRID_SYNC();
#if GEMM_MASK & 64
        { PP p = getpp(); unsigned char* ws = p->ws; const unsigned char* wl = ws + WS_W + (size_t)l * W_LAYER;
          EpiDown E{(float*)(ws + WS_X), (bf16_t*)(ws + WS_XB), SSP(ws, SS_X, l + 1)}; run_gemm(lds, (const bf16_t*)(ws + WS_HM), (const bf16_t*)(wl + W_DN), 2048, DFF_, E); }
#endif
        GRID_SYNC();
    }
    final_norm(getpp());
}

extern "C" void kernel_launch(void* const* d_in, const int* in_sizes, int n_in, void* d_out, int out_size, void* d_ws, size_t ws_size, hipStream_t stream) {
    static int grid = 0;
    if (grid == 0) {
        if (n_in != 26 || out_size != M_ * D_ || ws_size < WS_END) { fprintf(stderr, "kernel_launch: unexpected shapes: n_in %d out %d ws %zu (need %zu)\n", n_in, out_size, ws_size, (size_t)WS_END); grid = -1; return; }
        int dev = 0, cus = 0, per_cu = 0;
        hipGetDevice(&dev); hipDeviceGetAttribute(&cus, hipDeviceAttributeMultiprocessorCount, dev);
        if (hipFuncSetAttribute((const void*)hymba_fwd, hipFuncAttributeMaxDynamicSharedMemorySize, LDS_BYTES) != hipSuccess) { fprintf(stderr, "kernel_launch: hipFuncSetAttribute failed\n"); grid = -1; return; }
        if (hipOccupancyMaxActiveBlocksPerMultiprocessor(&per_cu, (const void*)hymba_fwd, 512, LDS_BYTES) != hipSuccess || per_cu < 1) { fprintf(stderr, "kernel_launch: occupancy query gave %d\n", per_cu); per_cu = 1; }
        (void)hipGetLastError();
        grid = cus * 1;
        fprintf(stderr, "kernel_launch: grid %d (per_cu %d)\n", grid, per_cu);
    }
    if (grid < 0) return;
    if (hipMemsetAsync((char*)d_ws + WS_CTL, 0, 65536, stream) != hipSuccess) { fprintf(stderr, "kernel_launch: memset failed\n"); return; }
    Params p{};
    for (int i = 0; i < 26; ++i) p.in[i] = (const float*)d_in[i];
    p.out = (float*)d_out; p.ws = (unsigned char*)d_ws;
    void* args[] = {&p};
    hipError_t e = hipLaunchCooperativeKernel((const void*)hymba_fwd, dim3(grid), dim3(512), args, LDS_BYTES, stream);
    if (e != hipSuccess) fprintf(stderr, "cooperative launch failed: %s (grid %d)\n", hipGetErrorString(e), grid);
}
```

```cpp
#include <hip/hip_runtime.h>
#include <hip/hip_cooperative_groups.h>
#include <cstdio>
#include <cstdint>
namespace cg = cooperative_groups;
#ifndef DUP_MIX
#define DUP_MIX 0
#endif
#ifndef DUP_GEMM
#define DUP_GEMM 0
#endif
#ifndef GEMM_MASK
#define GEMM_MASK 127
#endif

#define LAS __attribute__((address_space(3)))
typedef unsigned short bf16_t;
typedef short bf16x8 __attribute__((ext_vector_type(8)));
typedef short s16x4 __attribute__((ext_vector_type(4)));
typedef float f32x4 __attribute__((ext_vector_type(4)));
typedef float f32x2 __attribute__((ext_vector_type(2)));
typedef float f32x16 __attribute__((ext_vector_type(16)));
typedef unsigned u32x4 __attribute__((ext_vector_type(4)));
typedef unsigned u32x2 __attribute__((ext_vector_type(2)));
typedef __bf16 bf16x2_t __attribute__((ext_vector_type(2)));
#define DI __device__ __forceinline__

constexpr int M_ = 8192, D_ = 2048, SEQ_ = 2048, DEPTH_ = 4;
constexpr int NIN_ = 3072  , DFF_ = 5632;
constexpr float EPS_ = 1e-6f;
constexpr float LOG2E = 1.4426950408889634f;
constexpr float QSCALE_MLA = 0.07216878364870322f * LOG2E;
constexpr float QSCALE_DIL = 0.125f * LOG2E;

constexpr size_t MiB = 1u << 20;
constexpr size_t WS_CTL = 0;
constexpr size_t WS_ROPE = 1 * MiB;
constexpr size_t WS_ABAR = WS_ROPE + 512 * 1024;
constexpr size_t WS_A64 = WS_ABAR + 64 * 1024;
constexpr size_t WS_BB = 2 * MiB;
constexpr size_t WS_CT = 3 * MiB;
constexpr size_t WS_SST = 6 * MiB;
constexpr size_t WS_W = 8 * MiB;
constexpr size_t W_IN = 0, W_UQ = 12 * MiB, W_UKV = W_UQ + 3 * MiB / 2, W_GLU = W_UKV + 1 * MiB, W_O = W_GLU + 1 * MiB, W_GU = W_O + 8 * MiB, W_DN = W_GU + 44 * MiB, W_LAYER = W_DN + 22 * MiB;
constexpr size_t WS_X = WS_W + 4 * W_LAYER;
constexpr size_t WS_XB = WS_X + 64 * MiB;
constexpr size_t WS_MIX = WS_XB + 32 * MiB;
constexpr size_t WS_CQ = WS_MIX, WS_CKV = WS_CQ + 8 * MiB, WS_KPE = WS_CKV + 4 * MiB, WS_U = WS_KPE + 1 * MiB, WS_QD = WS_U + 16 * MiB, WS_KD = WS_QD + 8 * MiB, WS_VD = WS_KD + 8 * MiB,
                 WS_Q = WS_VD + 8 * MiB, WS_KV = WS_Q + 24 * MiB, WS_DP = WS_KV + 32 * MiB, WS_DLSE = WS_DP + 48 * MiB, WS_YCAT = WS_DLSE + 1 * MiB, WS_YG = WS_YCAT + 32 * MiB, WS_MIXEND = WS_YG + 8 * MiB;
constexpr size_t WS_HM = WS_MIX;
constexpr size_t WS_BBB = WS_MIXEND;
constexpr size_t WS_CTB = WS_BBB + 512 * 1024;
constexpr size_t WS_SS = WS_CTB + 512 * 1024;
constexpr size_t WS_END = WS_SS + 2 * MiB;
static_assert(WS_HM + (size_t)M_ * DFF_ * 2 <= WS_MIXEND, "HM overlay");
constexpr int SS_X = 0  , SS_Q = 5, SS_KV = 9, SS_SSM = 13, SS_MLA = 17, SS_DIL = 21, SS_X1 = 25, SS_N = 29;

constexpr int LDS_BYTES = 147456;

DI int opaque_tid() { int t = threadIdx.x; asm volatile("" : "+v"(t)); return t; }
typedef unsigned long long ssacc_t;
DI void ss_add(ssacc_t* p, float v) { atomicAdd(p, (ssacc_t)__float2ull_rn(v * 4294967296.f)); }
DI void ss_set(ssacc_t* p, float v) { *p = (ssacc_t)__float2ull_rn(v * 4294967296.f); }
DI float ss_get(const ssacc_t* p) { const ssacc_t v = *p; return (float)(unsigned)(v >> 32) + (float)(unsigned)(v & 0xffffffffull) * 2.3283064365386963e-10f; }
DI unsigned cvtpk(float lo, float hi) { f32x2 v = {lo, hi}; bf16x2_t b = __builtin_convertvector(v, bf16x2_t); return __builtin_bit_cast(unsigned, b); }
DI float bf2f(bf16_t b) { return __builtin_bit_cast(float, (unsigned)b << 16); }
DI float fexp2(float x) { return __builtin_amdgcn_exp2f(x); }
DI float sigmoidf_(float x) { return __builtin_amdgcn_rcpf(1.f + fexp2(-LOG2E * x)); }

namespace pg8 {
constexpr int BM = 256, BK = 64, HALF = 128, HTB = HALF * BK * 2, STAGE_BYTES = 8 * HTB, NXCD = 8, WGM = 8;
__host__ __device__ __forceinline__ int lds_byte(int r, int c) { const int st = (r >> 4) * 2 + (c >> 5), rr = r & 15, cc = c & 31, ob = rr * 64 + cc * 2; return st * 1024 + (ob ^ (((ob >> 9) & 1) << 5)); }
__host__ __device__ __forceinline__ void stage_rc(int b, int& R, int& C) { const int st = b / 1024, sb = b % 1024, swz = sb ^ (((sb >> 9) & 1) << 5); R = (st >> 1) * 16 + swz / 64; C = (st & 1) * 32 + (swz % 64) / 2; }
__host__ __device__ __forceinline__ int perm32(int rho) { const int n = rho >> 4, i = rho & 15; return 8 * (i >> 2) + 4 * n + (i & 3); }
struct Unit { int pm, pn; };
struct Gemm { const bf16_t* A; const bf16_t* Bt; int M, N, K; };
struct StaticOrder {
    int nM, nN, nwg, G, c;
    __host__ __device__ __forceinline__ void init(int M, int N, int G_, int c_) { nM = M / BM; nN = N / BM; nwg = nM * nN; G = G_; c = c_; }
    __host__ __device__ __forceinline__ bool next(int i, Unit& u) const {
        const long L = (long)i * G + c; if (L >= nwg) return false;
        int wgid = (int)L; { const int q = nwg / NXCD, r = nwg % NXCD, xcd = wgid % NXCD, off = wgid / NXCD; wgid = (xcd < r ? xcd * (q + 1) : r * (q + 1) + (xcd - r) * q) + off; }
        const int nig = WGM * nN, gid = wgid / nig, fm = gid * WGM, gsz = (nM - fm) < WGM ? (nM - fm) : WGM;
        u.pm = fm + ((wgid % nig) % gsz); u.pn = (wgid % nig) / gsz; return true;
    }
};
template <class Epi, class Sched, bool ALIGN_EPI, bool SP2>
__device__ __forceinline__ void gemm_phase(LAS unsigned char* lds, const Gemm g, const Sched& S, const Epi& E) {
    const int tid = opaque_tid(), wid = __builtin_amdgcn_readfirstlane(tid >> 6), lane = tid & 63, wr = wid >> 2, wc = wid & 3, fr = lane & 15, fq = lane >> 4;
    int K = g.K; asm volatile("" : "+s"(K)); const int nt = K / BK;
    unsigned voffA, voffB;
    { int R, C; stage_rc(tid * 16, R, C); const int Rb = Epi::PERM ? ((R & ~31) + perm32(R & 31)) : R;
      voffA = (unsigned)(R * K + C) * 2u; voffB = (unsigned)(Rb * K + C) * 2u; }
    const size_t rdelta = (size_t)64 * K * 2;
    const size_t kstep = (size_t)(BK * 2);
    const size_t hstep = (size_t)HALF * K * 2;
    const size_t tstep = 2 * hstep;
    const unsigned ldsw = (unsigned)wid * 1024u;
    const int aoff = lds_byte(wr * 64 + fr, fq * 8), boff = lds_byte(wc * 32 + fr, fq * 8);
#define PG8_SA(b, h) (((b) * 2 + (h)) * HTB)
#define PG8_SB(b, h) ((4 + (b) * 2 + (h)) * HTB)
#define PG8_STAGE(bufoff, gbase, voff) do { _Pragma("unroll") for (int _i = 0; _i < 2; ++_i) \
        __builtin_amdgcn_global_load_lds((const unsigned*)((const char*)(gbase) + _i * rdelta + (voff)), (LAS unsigned*)(lds + (bufoff) + ldsw + _i * 8192), 16, 0, 0); } while (0)
#define PG8_LDA(dst, b, h) do { _Pragma("unroll") for (int m = 0; m < 4; ++m) _Pragma("unroll") for (int k = 0; k < 2; ++k) dst[m][k] = *(const LAS bf16x8*)(lds + PG8_SA(b, h) + aoff + m * 2048 + k * 1024); } while (0)
#define PG8_LDB(dst, b, h) do { _Pragma("unroll") for (int n = 0; n < 2; ++n) _Pragma("unroll") for (int k = 0; k < 2; ++k) dst[n][k] = *(const LAS bf16x8*)(lds + PG8_SB(b, h) + boff + n * 2048 + k * 1024); } while (0)
#define PG8_MMA(ai, bj, At, Bt) do { __builtin_amdgcn_s_setprio(1); _Pragma("unroll") for (int m = 0; m < 4; ++m) _Pragma("unroll") for (int n = 0; n < 2; ++n) _Pragma("unroll") for (int k = 0; k < 2; ++k) \
        acc[ai][bj][m][n] = __builtin_amdgcn_mfma_f32_16x16x32_bf16(Bt[n][k], At[m][k], acc[ai][bj][m][n], 0, 0, 0); __builtin_amdgcn_s_setprio(0); } while (0)
#define PG8_WAIT_V(n) asm volatile("s_waitcnt vmcnt(" #n ")" ::: "memory")
#define PG8_WAIT_L(n) asm volatile("s_waitcnt lgkmcnt(" #n ")" ::: "memory")
#define PG8_BAR __builtin_amdgcn_s_barrier()
#define PG8_SCHED __builtin_amdgcn_sched_barrier(0)
    Unit cur, nxt; int ui = 0;
    if (!S.next(0, cur)) return;
    f32x4 acc[2][2][4][2];
#pragma unroll
    for (int a = 0; a < 2; ++a)
#pragma unroll
        for (int b = 0; b < 2; ++b)
#pragma unroll
            for (int m = 0; m < 4; ++m)
#pragma unroll
                for (int n = 0; n < 2; ++n) acc[a][b][m][n] = (f32x4){0.f, 0.f, 0.f, 0.f};
    bf16x8 At[4][2], B0[2][2], B1[2][2];
    const char* cA = (const char*)g.A + (size_t)cur.pm * tstep; const char* cB = (const char*)g.Bt + (size_t)cur.pn * tstep;
    if constexpr (SP2) {
        PG8_STAGE(PG8_SB(0, 0), cB, voffB); PG8_STAGE(PG8_SB(0, 1), cB + hstep, voffB); PG8_STAGE(PG8_SA(0, 0), cA, voffA); PG8_STAGE(PG8_SA(0, 1), cA + hstep, voffA);
        if (wr == 1) PG8_BAR;
        PG8_WAIT_V(2); PG8_BAR;
        PG8_STAGE(PG8_SB(1, 0), cB + kstep, voffB); PG8_STAGE(PG8_SA(1, 0), cA + kstep, voffA); PG8_STAGE(PG8_SB(1, 1), cB + hstep + kstep, voffB);
        PG8_WAIT_V(6); PG8_BAR;
    }
    for (;;) {
        const bool has_next = S.next(ui + 1, nxt);
        const char* nA = has_next ? (const char*)g.A + (size_t)nxt.pm * tstep : cA; const char* nB = has_next ? (const char*)g.Bt + (size_t)nxt.pn * tstep : cB;
        for (int t = 0; t < nt; t += 2) {
            if constexpr (Epi::HOOK) { if (t == Epi::T1 || t == Epi::T2) E.hook(acc, ui, t, wr, fr); }
            const bool last = (t == nt - 2);
            const char* a1 = cA + (size_t)(t + 1) * kstep;
            const char* a2 = last ? nA : cA + (size_t)(t + 2) * kstep; const char* b2 = last ? nB : cB + (size_t)(t + 2) * kstep;
            const char* a3 = a2 + kstep; const char* b3 = b2 + kstep;
            PG8_LDB(B0, 0, 0); PG8_LDB(B1, 0, 1); PG8_SCHED; PG8_LDA(At, 0, 0); PG8_STAGE(PG8_SA(1, 1), a1 + hstep, voffA);
            PG8_WAIT_V(8); PG8_WAIT_L(0); PG8_BAR; PG8_MMA(0, 0, At, B0); PG8_MMA(0, 1, At, B1); PG8_BAR; PG8_SCHED;
            PG8_LDA(At, 0, 1); PG8_STAGE(PG8_SB(0, 0), b2, voffB); PG8_STAGE(PG8_SB(0, 1), b2 + hstep, voffB); PG8_STAGE(PG8_SA(0, 0), a2, voffA);
            PG8_WAIT_V(8); PG8_WAIT_L(0); PG8_BAR; PG8_MMA(1, 0, At, B0); PG8_MMA(1, 1, At, B1); PG8_BAR; PG8_SCHED;
            PG8_LDB(B0, 1, 0); PG8_LDB(B1, 1, 1); PG8_SCHED; PG8_LDA(At, 1, 0); PG8_STAGE(PG8_SA(0, 1), a2 + hstep, voffA);
            PG8_WAIT_V(8); PG8_WAIT_L(0); PG8_BAR; PG8_MMA(0, 0, At, B0); PG8_MMA(0, 1, At, B1); PG8_BAR; PG8_SCHED;
            PG8_LDA(At, 1, 1); PG8_STAGE(PG8_SB(1, 0), b3, voffB); PG8_STAGE(PG8_SB(1, 1), b3 + hstep, voffB); PG8_STAGE(PG8_SA(1, 0), a3, voffA);
            PG8_WAIT_V(8); PG8_WAIT_L(0); PG8_BAR; PG8_MMA(1, 0, At, B0); PG8_MMA(1, 1, At, B1); PG8_BAR; PG8_SCHED;
        }
        if constexpr (ALIGN_EPI) { if (wr == 0) PG8_BAR; }
        E(acc, cur, wr, wc, fr, fq);
        if (!has_next) break;
#pragma unroll
        for (int a = 0; a < 2; ++a)
#pragma unroll
            for (int b = 0; b < 2; ++b)
#pragma unroll
                for (int m = 0; m < 4; ++m)
#pragma unroll
                    for (int n = 0; n < 2; ++n) acc[a][b][m][n] = (f32x4){0.f, 0.f, 0.f, 0.f};
        cur = nxt; cA = nA; cB = nB; ++ui;
        if constexpr (ALIGN_EPI) { if (wr == 1) PG8_BAR; }
    }
    PG8_WAIT_V(0);
    if constexpr (!ALIGN_EPI) { if (wr == 0) PG8_BAR; }
    PG8_BAR;
#undef PG8_SA
#undef PG8_SB
#undef PG8_STAGE
#undef PG8_LDA
#undef PG8_LDB
#undef PG8_MMA
#undef PG8_WAIT_V
#undef PG8_WAIT_L
#undef PG8_BAR
#undef PG8_SCHED
}
}
using pg8::Unit;
typedef f32x4 Acc[2][2][4][2];

struct Params {
    const float* in[26];
    float* out;
    unsigned char* ws;
};

typedef const __attribute__((address_space(4))) Params* PP;
DI PP getpp() { PP pp = (PP)__builtin_amdgcn_kernarg_segment_ptr(); asm volatile("" : "+s"(pp)); return pp; }
DI float quad_sum(float s) { s += __shfl_xor(s, 16); s += __shfl_xor(s, 32); return s; }
DI float sq8(const f32x4& a, const f32x4& b) { return (a[0] * a[0] + a[1] * a[1]) + (a[2] * a[2] + a[3] * a[3]) + (b[0] * b[0] + b[1] * b[1]) + (b[2] * b[2] + b[3] * b[3]); }
DI u32x4 pack8(const f32x4& a, const f32x4& b) { u32x4 w; w.x = cvtpk(a[0], a[1]); w.y = cvtpk(a[2], a[3]); w.z = cvtpk(b[0], b[1]); w.w = cvtpk(b[2], b[3]); return w; }
DI void rope8(f32x4& a, f32x4& b, const float* rope, int pos, int j0) {
    const f32x4 cs0 = *(const f32x4*)(rope + ((size_t)pos * 32 + j0) * 2), cs1 = *(const f32x4*)(rope + ((size_t)pos * 32 + j0 + 2) * 2);
    f32x4 o0, o1;
    o0[0] = a[0] * cs0[0] - a[1] * cs0[1]; o0[1] = a[1] * cs0[0] + a[0] * cs0[1];
    o0[2] = a[2] * cs0[2] - a[3] * cs0[3]; o0[3] = a[3] * cs0[2] + a[2] * cs0[3];
    o1[0] = b[0] * cs1[0] - b[1] * cs1[1]; o1[1] = b[1] * cs1[0] + b[0] * cs1[1];
    o1[2] = b[2] * cs1[2] - b[3] * cs1[3]; o1[3] = b[3] * cs1[2] + b[2] * cs1[3];
    a = o0; b = o1;
}

struct EpiInProj {
    static constexpr bool PERM = true, HOOK = false; static constexpr int T1 = -1, T2 = -1;
    unsigned char* ws; int l;
    DI void hook(Acc&, int, int, int, int) const {}
    DI void operator()(const Acc& acc, const Unit& u, int wr, int wc, int fr, int fq) const {
        const int pn = u.pn;
        const ssacc_t* ssx = (const ssacc_t*)(ws + WS_SS) + (size_t)(SS_X + l) * M_; const float* rope = (const float*)(ws + WS_ROPE);
        bf16_t *CQ = (bf16_t*)(ws + WS_CQ), *CKV = (bf16_t*)(ws + WS_CKV), *QD = (bf16_t*)(ws + WS_QD), *KD = (bf16_t*)(ws + WS_KD), *VD = (bf16_t*)(ws + WS_VD), *KPE = (bf16_t*)(ws + WS_KPE);
        float* U = (float*)(ws + WS_U); ssacc_t *ssq = (ssacc_t*)(ws + WS_SS) + (size_t)(SS_Q + l) * M_, *sskv = (ssacc_t*)(ws + WS_SS) + (size_t)(SS_KV + l) * M_;
#pragma unroll
        for (int ai = 0; ai < 2; ++ai)
#pragma unroll
            for (int m = 0; m < 4; ++m) {
                asm volatile("" ::: "memory");
                const int row = u.pm * 256 + ai * 128 + wr * 64 + m * 16 + fr;
                const float rs = rsqrtf(ss_get(ssx + row) * (1.f / 2048.f) + EPS_);
                float sq = 0.f;
#pragma unroll
                for (int bj = 0; bj < 2; ++bj) {
                    f32x4 v0 = acc[ai][bj][m][0] * rs, v1 = acc[ai][bj][m][1] * rs;
                    const int ct = bj * 128 + wc * 32 + 8 * fq;
                    if (pn <= 1) { *(u32x4*)(CQ + (size_t)row * 512 + pn * 256 + ct) = pack8(v0, v1); sq += sq8(v0, v1); }
                    else if (pn == 2) { *(u32x4*)(CKV + (size_t)row * 256 + ct) = pack8(v0, v1); sq += sq8(v0, v1); }
                    else if (pn <= 4) { float* p = U + (size_t)row * 512 + (pn - 3) * 256 + ct; *(f32x4*)p = v0; *(f32x4*)(p + 4) = v1; }
                    else if (pn <= 6) { v0 = v0 * QSCALE_DIL; v1 = v1 * QSCALE_DIL; *(u32x4*)(QD + (size_t)row * 512 + (pn - 5) * 256 + ct) = pack8(v0, v1); }
                    else if (pn <= 8) { *(u32x4*)(KD + (size_t)row * 512 + (pn - 7) * 256 + ct) = pack8(v0, v1); }
                    else if (pn <= 10) { *(u32x4*)(VD + (size_t)row * 512 + (pn - 9) * 256 + ct) = pack8(v0, v1); }
                    else { if (ct < 64) { rope8(v0, v1, rope, row & 2047, ct >> 1); *(u32x4*)(KPE + (size_t)row * 64 + ct) = pack8(v0, v1); } }
                }
                if (pn <= 2) { sq = quad_sum(sq); if (fq == 0) ss_add((pn <= 1 ? ssq : sskv) + row, sq); }
            }
    }
};
struct EpiQUp {
    static constexpr bool PERM = true, HOOK = false; static constexpr int T1 = -1, T2 = -1;
    const ssacc_t* ssq; const float* rope; bf16_t* Q;
    DI void hook(Acc&, int, int, int, int) const {}
    DI void operator()(const Acc& acc, const Unit& u, int wr, int wc, int fr, int fq) const {
#pragma unroll
        for (int ai = 0; ai < 2; ++ai)
#pragma unroll
            for (int m = 0; m < 4; ++m) {
                asm volatile("" ::: "memory");
                const int row = u.pm * 256 + ai * 128 + wr * 64 + m * 16 + fr;
                const float rs = rsqrtf(ss_get(ssq + row) * (1.f / 512.f) + EPS_) * QSCALE_MLA;
#pragma unroll
                for (int bj = 0; bj < 2; ++bj) {
                    f32x4 v0 = acc[ai][bj][m][0] * rs, v1 = acc[ai][bj][m][1] * rs;
                    const int c0 = u.pn * 256 + bj * 128 + wc * 32 + 8 * fq;
                    const int w = c0 % 192;
                    if (w >= 128) rope8(v0, v1, rope, row & 2047, (w - 128) >> 1);
                    *(u32x4*)(Q + (size_t)row * 1536 + c0) = pack8(v0, v1);
                }
            }
    }
};
struct EpiKvUp {
    static constexpr bool PERM = true, HOOK = false; static constexpr int T1 = -1, T2 = -1;
    const ssacc_t* sskv; bf16_t* KV;
    DI void hook(Acc&, int, int, int, int) const {}
    DI void operator()(const Acc& acc, const Unit& u, int wr, int wc, int fr, int fq) const {
#pragma unroll
        for (int ai = 0; ai < 2; ++ai)
#pragma unroll
            for (int m = 0; m < 4; ++m) {
                asm volatile("" ::: "memory");
                const int row = u.pm * 256 + ai * 128 + wr * 64 + m * 16 + fr;
                const float rs = rsqrtf(ss_get(sskv + row) * (1.f / 256.f) + EPS_);
#pragma unroll
                for (int bj = 0; bj < 2; ++bj) {
                    const f32x4 v0 = acc[ai][bj][m][0] * rs, v1 = acc[ai][bj][m][1] * rs;
                    const int c0 = u.pn * 256 + bj * 128 + wc * 32 + 8 * fq;
                    *(u32x4*)(KV + (size_t)row * 2048 + c0) = pack8(v0, v1);
                }
            }
    }
};
struct EpiGlu {
    static constexpr bool PERM = true, HOOK = false; static constexpr int T1 = -1, T2 = -1;
    const float* bglu; bf16_t* YCAT; ssacc_t* ss;
    DI void hook(Acc&, int, int, int, int) const {}
    DI void operator()(const Acc& acc, const Unit& u, int wr, int wc, int fr, int fq) const {
#pragma unroll
        for (int ai = 0; ai < 2; ++ai)
#pragma unroll
            for (int m = 0; m < 4; ++m) {
                asm volatile("" ::: "memory");
                const int row = u.pm * 256 + ai * 128 + wr * 64 + m * 16 + fr;
                float sq = 0.f;
#pragma unroll
                for (int bj = 0; bj < 2; ++bj) {
                    const f32x4 v0 = acc[ai][bj][m][0], v1 = acc[ai][bj][m][1];
                    const int i0 = (u.pn * 256 + bj * 128 + wc * 32 + 8 * fq) >> 1;
                    const f32x4 b1 = *(const f32x4*)(bglu + i0), b2 = *(const f32x4*)(bglu + 512 + i0);
                    const float o0 = (v0[0] + b1[0]) * sigmoidf_(v0[1] + b2[0]), o1 = (v0[2] + b1[1]) * sigmoidf_(v0[3] + b2[1]);
                    const float o2 = (v1[0] + b1[2]) * sigmoidf_(v1[1] + b2[2]), o3 = (v1[2] + b1[3]) * sigmoidf_(v1[3] + b2[3]);
                    sq += (o0 * o0 + o1 * o1) + (o2 * o2 + o3 * o3);
                    u32x2 w; w.x = cvtpk(o0, o1); w.y = cvtpk(o2, o3);
                    *(u32x2*)(YCAT + (size_t)row * 2048 + i0) = w;
                }
                sq = quad_sum(sq); if (fq == 0) ss_add(ss + row, sq);
            }
    }
};
struct EpiWo {
    static constexpr bool PERM = true, HOOK = true; static constexpr int T1 = 8, T2 = 24;
    unsigned char* ws; int l; const float* xin;
    const LAS float* FT;
    DI void hook(Acc& acc, int ui, int t, int wr, int fr) const {
        const LAS float* ft = FT + (ui * 2 + (t == T2 ? 1 : 0)) * 256 + wr * 64 + fr;
#pragma unroll
        for (int ai = 0; ai < 2; ++ai)
#pragma unroll
            for (int m = 0; m < 4; ++m) {
                const float f = ft[ai * 128 + m * 16];
#pragma unroll
                for (int bj = 0; bj < 2; ++bj) { acc[ai][bj][m][0] = acc[ai][bj][m][0] * f; acc[ai][bj][m][1] = acc[ai][bj][m][1] * f; }
            }
    }
    DI void operator()(const Acc& acc, const Unit& u, int wr, int wc, int fr, int fq) const {
        const ssacc_t* ss_dil = (const ssacc_t*)(ws + WS_SS) + (size_t)(SS_DIL + l) * M_; ssacc_t* ssx1 = (ssacc_t*)(ws + WS_SS) + (size_t)(SS_X1 + l) * M_;
        float* X = (float*)(ws + WS_X); bf16_t* XB = (bf16_t*)(ws + WS_XB);
#pragma unroll
        for (int ai = 0; ai < 2; ++ai)
#pragma unroll
            for (int m = 0; m < 4; ++m) {
                asm volatile("" ::: "memory");
                const int row = u.pm * 256 + ai * 128 + wr * 64 + m * 16 + fr;
                const float rs = rsqrtf(ss_get(ss_dil + row) * (1.f / 512.f) + EPS_);
                float sq = 0.f;
#pragma unroll
                for (int bj = 0; bj < 2; ++bj) {
                    const size_t off = (size_t)row * 2048 + u.pn * 256 + bj * 128 + wc * 32 + 8 * fq;
                    const f32x4 v0 = *(const f32x4*)(xin + off) + acc[ai][bj][m][0] * rs, v1 = *(const f32x4*)(xin + off + 4) + acc[ai][bj][m][1] * rs;
                    *(f32x4*)(X + off) = v0; *(f32x4*)(X + off + 4) = v1; *(u32x4*)(XB + off) = pack8(v0, v1); sq += sq8(v0, v1);
                }
                sq = quad_sum(sq); if (fq == 0) ss_add(ssx1 + row, sq);
            }
    }
};
struct EpiGateUp {
    static constexpr bool PERM = true, HOOK = false; static constexpr int T1 = -1, T2 = -1;
    const ssacc_t* ssx1; bf16_t* HM;
    DI void hook(Acc&, int, int, int, int) const {}
    DI void operator()(const Acc& acc, const Unit& u, int wr, int wc, int fr, int fq) const {
#pragma unroll
        for (int ai = 0; ai < 2; ++ai)
#pragma unroll
            for (int m = 0; m < 4; ++m) {
                asm volatile("" ::: "memory");
                const int row = u.pm * 256 + ai * 128 + wr * 64 + m * 16 + fr;
                const float rs = rsqrtf(ss_get(ssx1 + row) * (1.f / 2048.f) + EPS_);
#pragma unroll
                for (int bj = 0; bj < 2; ++bj) {
                    const f32x4 v0 = acc[ai][bj][m][0] * rs, v1 = acc[ai][bj][m][1] * rs;
                    const int i0 = (u.pn * 256 + bj * 128 + wc * 32 + 8 * fq) >> 1;
                    const float o0 = v0[0] * sigmoidf_(v0[0]) * v0[1], o1 = v0[2] * sigmoidf_(v0[2]) * v0[3];
                    const float o2 = v1[0] * sigmoidf_(v1[0]) * v1[1], o3 = v1[2] * sigmoidf_(v1[2]) * v1[3];
                    u32x2 w; w.x = cvtpk(o0, o1); w.y = cvtpk(o2, o3);
                    *(u32x2*)(HM + (size_t)row * DFF_ + i0) = w;
                }
            }
    }
};
struct EpiDown {
    static constexpr bool PERM = true, HOOK = false; static constexpr int T1 = -1, T2 = -1;
    float* X; bf16_t* XB; ssacc_t* ssx;
    DI void hook(Acc&, int, int, int, int) const {}
    DI void operator()(const Acc& acc, const Unit& u, int wr, int wc, int fr, int fq) const {
#pragma unroll
        for (int ai = 0; ai < 2; ++ai)
#pragma unroll
            for (int m = 0; m < 4; ++m) {
                asm volatile("" ::: "memory");
                const int row = u.pm * 256 + ai * 128 + wr * 64 + m * 16 + fr;
                float sq = 0.f;
#pragma unroll
                for (int bj = 0; bj < 2; ++bj) {
                    const size_t off = (size_t)row * 2048 + u.pn * 256 + bj * 128 + wc * 32 + 8 * fq;
                    const f32x4 v0 = *(const f32x4*)(X + off) + acc[ai][bj][m][0], v1 = *(const f32x4*)(X + off + 4) + acc[ai][bj][m][1];
                    *(f32x4*)(X + off) = v0; *(f32x4*)(X + off + 4) = v1; *(u32x4*)(XB + off) = pack8(v0, v1); sq += sq8(v0, v1);
                }
                sq = quad_sum(sq); if (fq == 0) ss_add(ssx + row, sq);
            }
    }
};

template <class Epi>
DI void run_gemm(LAS unsigned char* lds, const bf16_t* A, const bf16_t* Bt, int N, int K, const Epi& E) {
    pg8::Gemm g{A, Bt, M_, N, K}; pg8::StaticOrder S; S.init(M_, N, (int)gridDim.x, (int)blockIdx.x);
#if !defined(NO_GEMM)
    pg8::gemm_phase<Epi, pg8::StaticOrder, true, true>(lds, g, S, E);
#endif
    __syncthreads();
}

DI float wave_sum(float v) {
#pragma unroll
    for (int o = 1; o < 64; o <<= 1) v += __shfl_xor(v, o);
    return v;
}
template <int KIND> DI int map_n(int n) {
    if (KIND == 0) {
        if (n < 768) return n;
        if (n < 832) { const int j = n - 768; return 2816 + (j < 32 ? 2 * j : 2 * (j - 32) + 1); }
        return n - 64;
    }
    if (KIND == 1) {
        const int hd = n / 192, w = n % 192;
        if (w < 128) return n;
        const int j = w - 128; return hd * 192 + 128 + (j < 32 ? 2 * j : 2 * (j - 32) + 1);
    }
    if (KIND == 3) return n < 512 ? 2 * n : 2 * (n - 512) + 1;
    if (KIND == 5) return 2 * n;
    if (KIND == 6) return 2 * n + 1;
    return n;
}
template <int KIND>
DI void transpose_item(const float* W, int K, int N, bf16_t* WT, int ldk, const float* g0, const float* g1, const float* g2, LAS float* scr, int item, int lane) {
    const int nblk = N / 32, kb = item / nblk, nb = item % nblk, k0 = 64 * kb, n0 = 32 * nb;
    f32x4 tv[8];
#pragma unroll
    for (int i = 0; i < 8; ++i) tv[i] = __builtin_nontemporal_load((const f32x4*)(W + (size_t)(k0 + 8 * i + (lane >> 3)) * N + n0 + 4 * (lane & 7)));
#pragma unroll
    for (int i = 0; i < 8; ++i) {
        const int kk = 8 * i + (lane >> 3), k = k0 + kk;
        float gn = 1.f;
        if (KIND == 0 || KIND == 1 || KIND == 2 || KIND == 5 || KIND == 6) gn = g0[k];
        if (KIND == 4) gn = k < 1024 ? g0[k] : (k < 1536 ? g1[k - 1024] : g2[k - 1536]);
        LAS float* d = scr + kk * 33 + 4 * (lane & 7);
        d[0] = tv[i][0] * gn; d[1] = tv[i][1] * gn; d[2] = tv[i][2] * gn; d[3] = tv[i][3] * gn;
    }
    asm volatile("s_waitcnt lgkmcnt(0)" ::: "memory");
    int kd0 = k0;
    if (KIND == 4) kd0 = k0 < 1024 ? k0 + 512 : (k0 < 1536 ? k0 - 1024 : k0);
    const int c = lane & 7;
#pragma unroll
    for (int j = 0; j < 4; ++j) { const int n = (lane >> 3) + 8 * j; const LAS float* s = scr + (8 * c) * 33 + n;
        u32x4 o; o.x = cvtpk(s[0 * 33], s[1 * 33]); o.y = cvtpk(s[2 * 33], s[3 * 33]); o.z = cvtpk(s[4 * 33], s[5 * 33]); o.w = cvtpk(s[6 * 33], s[7 * 33]);
        *(u32x4*)(WT + (size_t)map_n<KIND>(n0 + n) * ldk + kd0 + 8 * c) = o; }
    asm volatile("s_waitcnt lgkmcnt(0)" ::: "memory");
}

DI void prologue(PP p, LAS unsigned char* lds) {
    const int tid = opaque_tid(), lane = tid & 63, wid = __builtin_amdgcn_readfirstlane(tid >> 6);
    const int gw = blockIdx.x * 8 + wid, NGW = gridDim.x * 8;
    const int gt = blockIdx.x * 512 + tid, NGT = gridDim.x * 512;
    unsigned char* ws = p->ws;
    { ssacc_t* ss = (ssacc_t*)(ws + WS_SS); for (int i = gt; i < (SS_N - 1) * M_; i += NGT) ss[M_ + i] = 0ull; }
    {
        const float* x = p->in[0]; bf16_t* XB = (bf16_t*)(ws + WS_XB); ssacc_t* ss = (ssacc_t*)(ws + WS_SS);
        for (int m = gw; m < M_; m += NGW) {
            const f32x4* xr = (const f32x4*)(x + (size_t)m * D_) + lane * 2; float s = 0.f;
#pragma unroll
            for (int j = 0; j < 4; ++j) { const f32x4 a = xr[128 * j], b = xr[128 * j + 1]; s += sq8(a, b); *(u32x4*)(XB + (size_t)m * D_ + j * 512 + lane * 8) = pack8(a, b); }
            s = wave_sum(s); if (lane == 0) ss_set(ss + m, s);
        }
    }
    {
        float* rope = (float*)(ws + WS_ROPE);
        for (int i = gt; i < 2048 * 32; i += NGT) {
            const int pos = i >> 5, j = i & 31;
            const double inv = exp(-(double)j * (9.210340371976184 / 32.0));
            double rev = (double)pos * inv * 0.15915494309189535; rev -= rint(rev);
            float sn, cs; sincosf((float)(rev * 6.283185307179586), &sn, &cs);
            rope[2 * i] = cs; rope[2 * i + 1] = sn;
        }
    }
    {
        const float *a_re = p->in[7], *a_im = p->in[8], *b_re = p->in[9], *b_im = p->in[10], *c_re = p->in[11], *c_im = p->in[12], *log_dt = p->in[14];
        float* ABAR = (float*)(ws + WS_ABAR); float* A64 = (float*)(ws + WS_A64); float* BB = (float*)(ws + WS_BB); float* CT = (float*)(ws + WS_CT);
        for (int i = gt; i < 4 * 32 * 64; i += NGT) {
            const int lg = i >> 6;
            const float lre = fminf(a_re[i], -1e-4f), lim = a_im[i];
            const float dt = __expf(log_dt[lg]);
            const double xr = (double)lre * (double)dt, th = (double)lim * (double)dt;
            double rev = th * 0.15915494309189535; rev -= rint(rev);
            const float r = (float)(rev * 6.283185307179586);
            float sn, cs; sincosf(r, &sn, &cs);
            const float ex = __expf((float)xr), em1 = expm1f((float)xr);
            ABAR[2 * i] = ex * cs; ABAR[2 * i + 1] = ex * sn;
            { double rev2 = th * 64.0 * 0.15915494309189535; rev2 -= rint(rev2); float s2, c2; sincosf((float)(rev2 * 6.283185307179586), &s2, &c2);
              const float e2 = __expf((float)(xr * 64.0)); A64[2 * i] = e2 * c2; A64[2 * i + 1] = e2 * s2; }
            float sh, ch; sincosf(0.5f * r, &sh, &ch);
            const float dre = em1 * cs - 2.f * sh * sh, dim = ex * sn;
            const float den = 1.f / (lre * lre + lim * lim);
            const float qre = (dre * lre + dim * lim) * den, qim = (dim * lre - dre * lim) * den;
            for (int pp = 0; pp < 16; ++pp) {
                const float br = b_re[(size_t)i * 16 + pp], bi = b_im[(size_t)i * 16 + pp];
                BB[((size_t)i * 16 + pp) * 2] = qre * br - qim * bi; BB[((size_t)i * 16 + pp) * 2 + 1] = qre * bi + qim * br;
                { bf16_t* BBb = (bf16_t*)(ws + WS_BBB); const int n = i & 63;
                  BBb[((size_t)lg * 128 + 2 * n) * 16 + pp] = (bf16_t)(cvtpk(qre * br - qim * bi, 0.f) & 0xffffu);
                  BBb[((size_t)lg * 128 + 2 * n + 1) * 16 + pp] = (bf16_t)(cvtpk(qre * bi + qim * br, 0.f) & 0xffffu); }
            }
        }
        for (int i = gt; i < 4 * 32 * 4 * 16 * 32; i += NGT) {
            const int kk = i & 31, pp = (i >> 5) & 15, kq = (i >> 9) & 3, lg = i >> 11, k = 32 * kq + kk;
            CT[i] = k < 64 ? c_re[((size_t)lg * 16 + pp) * 64 + k] : -c_im[((size_t)lg * 16 + pp) * 64 + (k - 64)];
        }
        for (int i = gt; i < 4 * 32 * 16 * 128; i += NGT) {
            const int k = i & 127, pp = (i >> 7) & 15, lg = i >> 11, n = k >> 1;
            const float v = (k & 1) ? -c_im[((size_t)lg * 16 + pp) * 64 + n] : c_re[((size_t)lg * 16 + pp) * 64 + n];
            ((bf16_t*)(ws + WS_CTB))[i] = (bf16_t)(cvtpk(v, 0.f) & 0xffffu);
        }
    }
}

DI void convert_weights(PP p, LAS unsigned char* lds, int l, int worker, int nworkers) {
    const int tid = opaque_tid(), lane = tid & 63, wid = __builtin_amdgcn_readfirstlane(tid >> 6);
    unsigned char* ws = p->ws;
    LAS float* scr = (LAS float*)(lds + wid * 16384);
    constexpr int I_IN = 32 * 90, I_UQ = 8 * 48, I_UKV = 4 * 64, I_GLU = 8 * 32, I_O = 32 * 64, I_G = 32 * 176, I_DN = 88 * 64;
    constexpr int I_LAYER = I_IN + I_UQ + I_UKV + I_GLU + I_O + 2 * I_G + I_DN;
    unsigned char* wl = ws + WS_W + (size_t)l * W_LAYER;
    for (int it = worker; it < I_LAYER; it += nworkers) {
        int r = it;
        if (r < I_IN) { transpose_item<0>(p->in[2] + (size_t)l * 2048 * 2880, 2048, 2880, (bf16_t*)(wl + W_IN), 2048, p->in[1] + l * 2048, nullptr, nullptr, scr, r, lane); continue; } r -= I_IN;
        if (r < I_UQ) { transpose_item<1>(p->in[4] + (size_t)l * 512 * 1536, 512, 1536, (bf16_t*)(wl + W_UQ), 512, p->in[3] + l * 512, nullptr, nullptr, scr, r, lane); continue; } r -= I_UQ;
        if (r < I_UKV) { transpose_item<2>(p->in[6] + (size_t)l * 256 * 2048, 256, 2048, (bf16_t*)(wl + W_UKV), 256, p->in[5] + l * 256, nullptr, nullptr, scr, r, lane); continue; } r -= I_UKV;
        if (r < I_GLU) { transpose_item<3>(p->in[15] + (size_t)l * 512 * 1024, 512, 1024, (bf16_t*)(wl + W_GLU), 512, nullptr, nullptr, nullptr, scr, r, lane); continue; } r -= I_GLU;
        if (r < I_O) { transpose_item<4>(p->in[20] + (size_t)l * 2048 * 2048, 2048, 2048, (bf16_t*)(wl + W_O), 2048, p->in[17] + l * 1024, p->in[18] + l * 512, p->in[19] + l * 512, scr, r, lane); continue; } r -= I_O;
        if (r < I_G) { transpose_item<5>(p->in[22] + (size_t)l * 2048 * DFF_, 2048, DFF_, (bf16_t*)(wl + W_GU), 2048, p->in[21] + l * 2048, nullptr, nullptr, scr, r, lane); continue; } r -= I_G;
        if (r < I_G) { transpose_item<6>(p->in[23] + (size_t)l * 2048 * DFF_, 2048, DFF_, (bf16_t*)(wl + W_GU), 2048, p->in[21] + l * 2048, nullptr, nullptr, scr, r, lane); continue; } r -= I_G;
        transpose_item<7>(p->in[24] + (size_t)l * DFF_ * 2048, DFF_, 2048, (bf16_t*)(wl + W_DN), DFF_, nullptr, nullptr, nullptr, scr, r, lane);
    }
}

DI int crow(int i, int h) { return (i & 3) + 8 * (i >> 2) + 4 * h; }
DI bf16x8 pack_step(const f32x16& x, int s) {
    u32x4 w; w.x = cvtpk(x[8 * s], x[8 * s + 1]); w.y = cvtpk(x[8 * s + 2], x[8 * s + 3]); w.z = cvtpk(x[8 * s + 4], x[8 * s + 5]); w.w = cvtpk(x[8 * s + 6], x[8 * s + 7]);
    return __builtin_bit_cast(bf16x8, w);
}
typedef short v4i16_t __attribute__((ext_vector_type(4)));
DI s16x4 vtr(const LAS unsigned char* p) { return __builtin_bit_cast(s16x4, __builtin_amdgcn_ds_read_tr16_b64_v4i16((LAS v4i16_t*)p)); }
#define MFMA32(a, b, c) __builtin_amdgcn_mfma_f32_32x32x16_bf16((a), (b), (c), 0, 0, 0)

struct AttnPtrs {
    unsigned char* ws; int l;
    DI const bf16_t* Q() const { return (const bf16_t*)(ws + WS_Q); }
    DI const bf16_t* KV() const { return (const bf16_t*)(ws + WS_KV); }
    DI const bf16_t* KPE() const { return (const bf16_t*)(ws + WS_KPE); }
    DI const bf16_t* QD() const { return (const bf16_t*)(ws + WS_QD); }
    DI const bf16_t* KD() const { return (const bf16_t*)(ws + WS_KD); }
    DI const bf16_t* VD() const { return (const bf16_t*)(ws + WS_VD); }
    DI bf16_t* YCAT() const { return (bf16_t*)(ws + WS_YCAT); }
    DI ssacc_t* ss_mla() const { return (ssacc_t*)(ws + WS_SS) + (size_t)(SS_MLA + l) * M_; }
    DI bf16_t* DP() const { return (bf16_t*)(ws + WS_DP); }
    DI float* DLSE() const { return (float*)(ws + WS_DLSE); }
};

template <int MODE, bool ATOM = true>
DI void attn_unit(LAS unsigned char* lds, const AttnPtrs& P, int b, int hd, int fi0, int dmul, int r0, int pat, int t_begin, int t_end) {
    constexpr int DQK = MODE == 0 ? 192 : 64, DV = MODE == 0 ? 128 : 64;
    constexpr int KSTR = (DQK + 8) * 2, VSTR = DV * 2 + 32;
    constexpr int CPK = DQK / 8, CPV = DV / 8, NKR = 128 * CPK / 512, NVR = 128 * CPV / 512;
    constexpr int NKK = DQK / 16, NDV = DV / 32;
    constexpr int span = MODE == 0 ? (1 << 30) : 128;
    LAS unsigned char* Ks = lds; LAS unsigned char* Vs = lds + 128 * KSTR;
    const int tid = opaque_tid(), lane = tid & 63, wid = __builtin_amdgcn_readfirstlane(tid >> 6), r = lane & 31, h = lane >> 5, rg = wid & 3, kh = wid >> 2;
    const int fq_ = fi0 + rg * 32 + r;
    const size_t tokq = (size_t)b * 2048 + (size_t)fq_ * dmul + r0;
    constexpr int NQF = MODE == 0 ? 1 : NKK;
    bf16x8 qf[NQF];
    LAS unsigned char* Qs = lds + 128 * KSTR + 128 * VSTR;
    const LAS unsigned char* Qw = Qs + (rg * 32 + r) * KSTR + h * 16;
    if (MODE == 0) {
        const bf16_t* qp = P.Q() + ((size_t)b * 2048 + fi0 + (tid >> 2)) * 1536 + hd * 192 + (tid & 3) * 8;
#pragma unroll
        for (int i = 0; i < 6; ++i) { const u32x4 v = *(const u32x4*)(qp + i * 32); *(LAS u32x4*)(Qs + (tid >> 2) * KSTR + (tid & 3) * 16 + i * 64) = v; }
    } else {
        const bf16_t* qp = P.QD() + tokq * 512 + hd * 64;
#pragma unroll
        for (int kk = 0; kk < NQF; ++kk) qf[kk] = *(const bf16x8*)(qp + kk * 16 + 8 * h);
    }
    f32x16 o[NDV];
#pragma unroll
    for (int d = 0; d < NDV; ++d)
#pragma unroll
        for (int i = 0; i < 16; ++i) o[d][i] = 0.f;
    float mrun = -INFINITY, lrun = 0.f;
    u32x4 kreg[NKR], vreg[NVR];
    const int lkey = tid >> 2, lq = tid & 3;
    const bf16_t* kp0; const bf16_t* kp1;
    if (MODE == 0) { const size_t tok = (size_t)b * 2048 + t_begin * 128 + lkey; kp0 = P.KV() + tok * 2048 + hd * 256 + lq * 8; kp1 = P.KPE() + tok * 64 + lq * 8; }
    else { const size_t tok = (size_t)b * 2048 + (size_t)(t_begin * 128 + lkey) * dmul + r0; kp0 = P.KD() + tok * 512 + hd * 64 + lq * 8; kp1 = P.VD() + tok * 512 + hd * 64 + lq * 8; }
    const size_t kstep0 = MODE == 0 ? (size_t)128 * 2048 : (size_t)128 * dmul * 512, kstep1 = MODE == 0 ? (size_t)128 * 64 : (size_t)128 * dmul * 512;
#define ATT_LOAD() do { \
        if (MODE == 0) { _Pragma("unroll") for (int i_ = 0; i_ < 4; ++i_) { kreg[i_] = *(const u32x4*)(kp0 + i_ * 32); vreg[i_] = *(const u32x4*)(kp0 + 128 + i_ * 32); } \
                         _Pragma("unroll") for (int i_ = 0; i_ < 2; ++i_) kreg[4 + (MODE == 0 ? i_ : 0)] = *(const u32x4*)(kp1 + i_ * 32); } \
        else { _Pragma("unroll") for (int i_ = 0; i_ < 2; ++i_) { kreg[i_] = *(const u32x4*)(kp0 + i_ * 32); vreg[i_] = *(const u32x4*)(kp1 + i_ * 32); } } \
        kp0 += kstep0; kp1 += kstep1; } while (0)
    ATT_LOAD();
    const LAS unsigned char* Kw = Ks + (kh * 64 + r) * KSTR + h * 16;
    const LAS unsigned char* Vw = Vs + (kh * 64 + 4 * h + ((lane & 15) >> 2)) * VSTR + (16 * ((lane >> 4) & 1) + 4 * (lane & 3)) * 2;
    for (int t = t_begin; t < t_end; ++t) {
        __syncthreads();
        {
            LAS unsigned char* kd = Ks + lkey * KSTR + lq * 16; LAS unsigned char* vd = Vs + lkey * VSTR + lq * 16;
            if (MODE == 0) {
#pragma unroll
                for (int i = 0; i < 4; ++i) { *(LAS u32x4*)(kd + i * 64) = kreg[i]; *(LAS u32x4*)(vd + i * 64) = vreg[i]; }
#pragma unroll
                for (int i = 0; i < 2; ++i) *(LAS u32x4*)(kd + 256 + i * 64) = kreg[4 + (MODE == 0 ? i : 0)];
            } else {
#pragma unroll
                for (int i = 0; i < 2; ++i) { *(LAS u32x4*)(kd + i * 64) = kreg[i]; *(LAS u32x4*)(vd + i * 64) = vreg[i]; }
            }
        }
        __syncthreads();
        if (t + 1 < t_end) ATT_LOAD();
        f32x16 x0, x1;
#pragma unroll
        for (int i = 0; i < 16; ++i) { x0[i] = 0.f; x1[i] = 0.f; }
#pragma unroll
        for (int kk = 0; kk < NKK; ++kk) {
            const bf16x8 a0 = *(const LAS bf16x8*)(Kw + kk * 32), a1 = *(const LAS bf16x8*)(Kw + 32 * KSTR + kk * 32);
            const bf16x8 qv = MODE == 0 ? *(const LAS bf16x8*)(Qw + kk * 32) : qf[MODE == 0 ? 0 : kk];
            x0 = MFMA32(a0, qv, x0); x1 = MFMA32(a1, qv, x1);
            if ((kk & 3) == 3) __builtin_amdgcn_sched_barrier(0);
        }
        const int keyb = t * 128 + kh * 64;
        if (MODE == 1 || t == t_end - 1) {
#pragma unroll
            for (int i = 0; i < 16; ++i) {
                const int k0 = keyb + crow(i, h), k1 = k0 + 32;
                if (k0 > fq_ || (MODE == 1 && k0 + span < fq_)) x0[i] = -INFINITY;
                if (k1 > fq_ || (MODE == 1 && k1 + span < fq_)) x1[i] = -INFINITY;
            }
        }
        float mloc = fmaxf(x0[0], x1[0]);
#pragma unroll
        for (int i = 1; i < 16; ++i) mloc = fmaxf(mloc, fmaxf(x0[i], x1[i]));
        mloc = fmaxf(mloc, __shfl_xor(mloc, 32));
        const float mnew = fmaxf(mrun, mloc);
        const float msafe = mnew == -INFINITY ? 0.f : mnew;
        const float alpha = fexp2(mrun - msafe);
        float psum = 0.f;
#pragma unroll
        for (int i = 0; i < 16; ++i) { x0[i] = fexp2(x0[i] - msafe); x1[i] = fexp2(x1[i] - msafe); psum += x0[i] + x1[i]; }
        lrun = lrun * alpha + psum; mrun = mnew;
        if (__builtin_amdgcn_ballot_w64(alpha != 1.f) != 0ull) {
#pragma unroll
            for (int d = 0; d < NDV; ++d)
#pragma unroll
                for (int i = 0; i < 16; ++i) o[d][i] *= alpha;
        }
#pragma unroll
        for (int ht = 0; ht < 2; ++ht)
#pragma unroll
            for (int s = 0; s < 2; ++s) {
                const bf16x8 pf = pack_step(ht == 0 ? x0 : x1, s);
#pragma unroll
                for (int d = 0; d < NDV; ++d) {
                    const s16x4 lo = vtr(Vw + (ht * 32 + 16 * s) * VSTR + d * 64), hi = vtr(Vw + (ht * 32 + 16 * s + 8) * VSTR + d * 64);
                    const bf16x8 pa = __builtin_shufflevector(lo, hi, 0, 1, 2, 3, 4, 5, 6, 7);
                    o[d] = MFMA32(pa, pf, o[d]);
                }
                __builtin_amdgcn_sched_barrier(0);
            }
    }
#undef ATT_LOAD
    lrun += __shfl_xor(lrun, 32);
    __syncthreads();
    LAS float* MS = (LAS float*)lds + rg * ((NDV * 16 + 2) * 64);
    if (kh == 1) {
#pragma unroll
        for (int d = 0; d < NDV; ++d)
#pragma unroll
            for (int i = 0; i < 16; ++i) MS[(d * 16 + i) * 64 + lane] = o[d][i];
        MS[(NDV * 16) * 64 + lane] = mrun; MS[(NDV * 16 + 1) * 64 + lane] = lrun;
    }
    __syncthreads();
    if (kh == 0) {
        const float m1 = MS[(NDV * 16) * 64 + lane], l1 = MS[(NDV * 16 + 1) * 64 + lane];
        const float mm = fmaxf(mrun, m1), ms = mm == -INFINITY ? 0.f : mm;
        const float f0 = fexp2(mrun - ms), f1 = fexp2(m1 - ms);
        const float lt = lrun * f0 + l1 * f1, inv = 1.f / lt;
        float sq = 0.f;
#pragma unroll
        for (int d = 0; d < NDV; ++d)
#pragma unroll
            for (int g = 0; g < 4; ++g) {
                f32x4 v;
#pragma unroll
                for (int e = 0; e < 4; ++e) v[e] = (o[d][4 * g + e] * f0 + MS[(d * 16 + 4 * g + e) * 64 + lane] * f1) * inv;
                const int dv = d * 32 + 8 * g + 4 * h;
                if (MODE == 0) { u32x2 w; w.x = cvtpk(v[0], v[1]); w.y = cvtpk(v[2], v[3]); *(u32x2*)(P.YCAT() + tokq * 2048 + 512 + hd * 128 + dv) = w; sq += (v[0] * v[0] + v[1] * v[1]) + (v[2] * v[2] + v[3] * v[3]); }
                else { u32x2 w; w.x = cvtpk(v[0], v[1]); w.y = cvtpk(v[2], v[3]); *(u32x2*)(P.DP() + ((size_t)pat * M_ + tokq) * 512 + hd * 64 + dv) = w; }
            }
        if (MODE == 0) { sq += __shfl_xor(sq, 32); if (ATOM && h == 0) ss_add(P.ss_mla() + tokq, sq); }
        else { if (h == 0) P.DLSE()[((size_t)pat * M_ + tokq) * 8 + hd] = mm + __log2f(lt); }
    }
}


template <bool ATOM>
DI void mla_unit(LAS unsigned char* lds, const AttnPtrs& P, int b, int hd, int qb) {
    constexpr int KSTR = 400, VSTR = 288, NKK = 12, NDV = 4, BUFB = 64 * KSTR + 64 * VSTR;
    const int tid = opaque_tid(), lane = tid & 63, wid = __builtin_amdgcn_readfirstlane(tid >> 6), r = lane & 31, h = lane >> 5, rg = wid & 3, kh = wid >> 2;
    const int fq_ = qb * 128 + rg * 32 + r;
    const size_t tokq = (size_t)b * 2048 + fq_;
    bf16x8 qf[NKK];
    { const bf16_t* qp = P.Q() + tokq * 1536 + hd * 192;
#pragma unroll
      for (int kk = 0; kk < NKK; ++kk) qf[kk] = *(const bf16x8*)(qp + kk * 16 + 8 * h); }
    f32x16 o[NDV];
#pragma unroll
    for (int d = 0; d < NDV; ++d)
#pragma unroll
        for (int i = 0; i < 16; ++i) o[d][i] = 0.f;
    float mrun = -INFINITY, lrun = 0.f;
    const int lkey = tid >> 3, lq = tid & 7;
    const bf16_t* kp0 = P.KV() + ((size_t)b * 2048 + lkey) * 2048 + hd * 256 + lq * 8;
    const bf16_t* kp1 = P.KPE() + ((size_t)b * 2048 + lkey) * 64 + lq * 8;
    u32x4 sreg[5];
#define MLA_LOAD() do { sreg[0] = *(const u32x4*)(kp0); sreg[1] = *(const u32x4*)(kp0 + 64); sreg[2] = *(const u32x4*)(kp0 + 128); sreg[3] = *(const u32x4*)(kp0 + 192); \
        sreg[4] = *(const u32x4*)(kp1); kp0 += (size_t)64 * 2048; kp1 += (size_t)64 * 64; } while (0)
#define MLA_WRITE(buf) do { LAS unsigned char* kd_ = lds + (buf) * BUFB + lkey * KSTR + lq * 16; LAS unsigned char* vd_ = lds + (buf) * BUFB + 64 * KSTR + lkey * VSTR + lq * 16; \
        *(LAS u32x4*)(kd_) = sreg[0]; *(LAS u32x4*)(kd_ + 128) = sreg[1]; *(LAS u32x4*)(kd_ + 256) = sreg[4]; *(LAS u32x4*)(vd_) = sreg[2]; *(LAS u32x4*)(vd_ + 128) = sreg[3]; } while (0)
    const int nsteps = 2 * (qb + 1);
    __syncthreads();
    MLA_LOAD(); MLA_WRITE(0);
    MLA_LOAD();
    __syncthreads();
    const int kwo = (kh * 32 + r) * KSTR + h * 16;
    const int vwo = 64 * KSTR + (kh * 32 + 4 * h + ((lane & 15) >> 2)) * VSTR + (16 * ((lane >> 4) & 1) + 4 * (lane & 3)) * 2;
    for (int t = 0; t < nsteps; ++t) {
        if (t + 1 < nsteps) MLA_WRITE((t + 1) & 1);
        if (t + 2 < nsteps) MLA_LOAD();
        const int keyb = t * 64 + kh * 32;
        if (keyb <= qb * 128 + rg * 32 + 31) {
            const LAS unsigned char* Kw = lds + (t & 1) * BUFB + kwo;
            const LAS unsigned char* Vw = lds + (t & 1) * BUFB + vwo;
            f32x16 xa, xb;
#pragma unroll
            for (int i = 0; i < 16; ++i) { xa[i] = 0.f; xb[i] = 0.f; }
#pragma unroll
            for (int kk = 0; kk < NKK; kk += 2) {
                const bf16x8 a0 = *(const LAS bf16x8*)(Kw + kk * 32), a1 = *(const LAS bf16x8*)(Kw + kk * 32 + 32);
                xa = MFMA32(a0, qf[kk], xa); xb = MFMA32(a1, qf[kk + 1], xb);
                if ((kk & 3) == 2) __builtin_amdgcn_sched_barrier(0);
            }
            f32x16 x0;
#pragma unroll
            for (int i = 0; i < 16; ++i) x0[i] = xa[i] + xb[i];
            if (keyb + 31 > qb * 128 + rg * 32) {
#pragma unroll
                for (int i = 0; i < 16; ++i) if (keyb + crow(i, h) > fq_) x0[i] = -INFINITY;
            }
            float mloc = x0[0];
#pragma unroll
            for (int i = 1; i < 16; ++i) mloc = fmaxf(mloc, x0[i]);
            mloc = fmaxf(mloc, __shfl_xor(mloc, 32));
            const float mnew = fmaxf(mrun, mloc);
            const float msafe = mnew == -INFINITY ? 0.f : mnew;
            const float alpha = fexp2(mrun - msafe);
            float psum = 0.f;
#pragma unroll
            for (int i = 0; i < 16; ++i) { x0[i] = fexp2(x0[i] - msafe); psum += x0[i]; }
            lrun = lrun * alpha + psum; mrun = mnew;
            if (__builtin_amdgcn_ballot_w64(alpha != 1.f) != 0ull) {
#pragma unroll
                for (int d = 0; d < NDV; ++d)
#pragma unroll
                    for (int i = 0; i < 16; ++i) o[d][i] *= alpha;
            }
#pragma unroll
            for (int s2 = 0; s2 < 2; ++s2) {
                const bf16x8 pf = pack_step(x0, s2);
#pragma unroll
                for (int d = 0; d < NDV; ++d) {
                    const s16x4 lo = vtr(Vw + (16 * s2) * VSTR + d * 64), hi = vtr(Vw + (16 * s2 + 8) * VSTR + d * 64);
                    const bf16x8 pa = __builtin_shufflevector(lo, hi, 0, 1, 2, 3, 4, 5, 6, 7);
                    o[d] = MFMA32(pa, pf, o[d]);
                }
                __builtin_amdgcn_sched_barrier(0);
            }
        }
        __syncthreads();
    }
#undef MLA_LOAD
#undef MLA_WRITE
    lrun += __shfl_xor(lrun, 32);
    LAS float* MS = (LAS float*)lds + rg * ((NDV * 16 + 2) * 64);
    if (kh == 1) {
#pragma unroll
        for (int d = 0; d < NDV; ++d)
#pragma unroll
            for (int i = 0; i < 16; ++i) MS[(d * 16 + i) * 64 + lane] = o[d][i];
        MS[(NDV * 16) * 64 + lane] = mrun; MS[(NDV * 16 + 1) * 64 + lane] = lrun;
    }
    __syncthreads();
    if (kh == 0) {
        const float m1 = MS[(NDV * 16) * 64 + lane], l1 = MS[(NDV * 16 + 1) * 64 + lane];
        const float mm = fmaxf(mrun, m1), ms = mm == -INFINITY ? 0.f : mm;
        const float f0 = fexp2(mrun - ms), f1 = fexp2(m1 - ms);
        const float lt = lrun * f0 + l1 * f1, inv = 1.f / lt;
        float sq = 0.f;
#pragma unroll
        for (int d = 0; d < NDV; ++d)
#pragma unroll
            for (int g = 0; g < 4; ++g) {
                f32x4 v;
#pragma unroll
                for (int e = 0; e < 4; ++e) v[e] = (o[d][4 * g + e] * f0 + MS[(d * 16 + 4 * g + e) * 64 + lane] * f1) * inv;
                const int dv = d * 32 + 8 * g + 4 * h;
                u32x2 w; w.x = cvtpk(v[0], v[1]); w.y = cvtpk(v[2], v[3]); *(u32x2*)(P.YCAT() + tokq * 2048 + 512 + hd * 128 + dv) = w; sq += (v[0] * v[0] + v[1] * v[1]) + (v[2] * v[2] + v[3] * v[3]);
            }
        sq += __shfl_xor(sq, 32); if (ATOM && h == 0) ss_add(P.ss_mla() + tokq, sq);
    }
}

DI void ssm_s1(PP p, LAS unsigned char* lds, int l) {
    const int tid = opaque_tid(), lane = tid & 63, wid = __builtin_amdgcn_readfirstlane(tid >> 6);
    unsigned char* ws = p->ws;
#define WSF(off) ((float*)(ws + (unsigned)(off)))
#define U WSF(WS_U)
#define ABAR WSF(WS_ABAR)
#define A64 WSF(WS_A64)
#define BB WSF(WS_BB)
#define CT WSF(WS_CT)
#define SST WSF(WS_SST)
    LAS float* US = (LAS float*)(lds + wid * 16384);
    for (int it = blockIdx.x * 8 + wid; it < 4 * 32 * 32; it += gridDim.x * 8) {
        const int g = it & 31, c = (it >> 5) & 31, b = it >> 10, lg = l * 32 + g;
        const size_t tok0 = (size_t)b * 2048 + c * 64;
        { const f32x4* up = (const f32x4*)(U + (tok0 + lane) * 512 + g * 16);
#pragma unroll
          for (int j = 0; j < 4; ++j) *(LAS f32x4*)(US + lane * 16 + 4 * j) = up[j]; }
        const float are = ABAR[(lg * 64 + lane) * 2], aim = ABAR[(lg * 64 + lane) * 2 + 1];
        f32x2 bb[16];
        { const f32x4* bp = (const f32x4*)(BB + ((size_t)(lg * 64 + lane) * 16) * 2);
#pragma unroll
          for (int j = 0; j < 8; ++j) { const f32x4 v = bp[j]; bb[2 * j] = (f32x2){v[0], v[1]}; bb[2 * j + 1] = (f32x2){v[2], v[3]}; } }
        asm volatile("s_waitcnt lgkmcnt(0)" ::: "memory");
        f32x2 hh = {0.f, 0.f}; const f32x2 a1 = {are, are}, a2 = {-aim, aim};
        for (int t = 0; t < 64; ++t) {
            f32x2 uu = {0.f, 0.f};
#pragma unroll
            for (int j = 0; j < 4; ++j) { const f32x4 uv = *(const LAS f32x4*)(US + t * 16 + 4 * j);
#pragma unroll
                for (int e = 0; e < 4; ++e) uu += bb[4 * j + e] * uv[e]; }
            hh = a1 * hh + a2 * (f32x2){hh[1], hh[0]} + uu;
        }
        *(f32x2*)(SST + ((size_t)((b * 32 + c) * 32 + g) * 64 + lane) * 2) = hh;
        asm volatile("s_waitcnt lgkmcnt(0)" ::: "memory");
    }
}
DI void ssm_s3(PP p, LAS unsigned char* lds, int l) {
    const int tid = opaque_tid(), lane = tid & 63, wid = __builtin_amdgcn_readfirstlane(tid >> 6);
    unsigned char* ws = p->ws;
    const float* dskip = p->in[13] + l * 512; bf16_t* YG = (bf16_t*)(ws + (unsigned)WS_YG);
    LAS float* US = (LAS float*)(lds + wid * 16384);
    LAS float* HS = US + 1024;
    for (int it = blockIdx.x * 8 + wid; it < 4 * 32 * 32; it += gridDim.x * 8) {
        const int g = it & 31, c = (it >> 5) & 31, b = it >> 10, lg = l * 32 + g;
        const size_t tok0 = (size_t)b * 2048 + c * 64;
        { const f32x4* up = (const f32x4*)(U + (tok0 + lane) * 512 + g * 16);
#pragma unroll
          for (int j = 0; j < 4; ++j) *(LAS f32x4*)(US + lane * 16 + 4 * j) = up[j]; }
        const float are = ABAR[(lg * 64 + lane) * 2], aim = ABAR[(lg * 64 + lane) * 2 + 1];
        const float a6re = A64[(lg * 64 + lane) * 2], a6im = A64[(lg * 64 + lane) * 2 + 1];
        f32x2 bb[16];
        { const f32x4* bp = (const f32x4*)(BB + ((size_t)(lg * 64 + lane) * 16) * 2);
#pragma unroll
          for (int j = 0; j < 8; ++j) { const f32x4 v = bp[j]; bb[2 * j] = (f32x2){v[0], v[1]}; bb[2 * j + 1] = (f32x2){v[2], v[3]}; } }
        float cc[32];
        { const f32x4* cp = (const f32x4*)(CT + ((size_t)(lg * 4 + (lane >> 4)) * 16 + (lane & 15)) * 32);
#pragma unroll
          for (int j = 0; j < 8; ++j) { const f32x4 v = cp[j]; cc[4 * j] = v[0]; cc[4 * j + 1] = v[1]; cc[4 * j + 2] = v[2]; cc[4 * j + 3] = v[3]; } }
        const float dsk = dskip[g * 16 + (lane & 15)];
        f32x2 hh = {0.f, 0.f}; const f32x2 a1 = {are, are}, a2 = {-aim, aim};
        { const f32x2* sp = (const f32x2*)SST + (size_t)(b * 32 * 32 + g) * 64 + lane;
          const f32x2 c1 = {a6re, a6re}, c2 = {-a6im, a6im};
          f32x2 sv[31];
#pragma unroll
          for (int cp_ = 0; cp_ < 31; ++cp_) sv[cp_] = cp_ < c ? sp[(size_t)cp_ * 32 * 64] : (f32x2){0.f, 0.f};
#pragma unroll
          for (int cp_ = 0; cp_ < 31; ++cp_) if (cp_ < c) hh = c1 * hh + c2 * (f32x2){hh[1], hh[0]} + sv[cp_]; }
        asm volatile("s_waitcnt lgkmcnt(0)" ::: "memory");
        for (int sc = 0; sc < 4; ++sc) {
            for (int t16 = 0; t16 < 16; ++t16) {
                const int t = sc * 16 + t16;
                f32x2 uu = {0.f, 0.f};
#pragma unroll
                for (int j = 0; j < 4; ++j) { const f32x4 uv = *(const LAS f32x4*)(US + t * 16 + 4 * j);
#pragma unroll
                    for (int e = 0; e < 4; ++e) uu += bb[4 * j + e] * uv[e]; }
                hh = a1 * hh + a2 * (f32x2){hh[1], hh[0]} + uu;
                HS[t16 * 132 + lane] = hh[0]; HS[t16 * 132 + 64 + lane] = hh[1];
            }
            asm volatile("s_waitcnt lgkmcnt(0)" ::: "memory");
            f32x4 acc = {0.f, 0.f, 0.f, 0.f};
            const LAS float* hp = HS + (lane & 15) * 132 + 32 * (lane >> 4);
#pragma unroll
            for (int j = 0; j < 8; ++j) { const f32x4 hv = *(const LAS f32x4*)(hp + 4 * j);
#pragma unroll
                for (int e = 0; e < 4; ++e) acc = __builtin_amdgcn_mfma_f32_16x16x4f32(hv[e], cc[4 * j + e], acc, 0, 0, 0); }
#pragma unroll
            for (int j = 0; j < 4; ++j) {
                const int t = sc * 16 + 4 * (lane >> 4) + j;
                float y = acc[j] + dsk * US[t * 16 + (lane & 15)];
                const float z = 0.7978845608028654f * (y + 0.044715f * y * y * y);
                const float th = 1.f - 2.f * __builtin_amdgcn_rcpf(1.f + fexp2(2.f * LOG2E * z));
                y = 0.5f * y * (1.f + th);
                YG[(tok0 + t) * 512 + g * 16 + (lane & 15)] = (bf16_t)(cvtpk(y, 0.f) & 0xffffu);
            }
            asm volatile("s_waitcnt lgkmcnt(0)" ::: "memory");
        }
    }
}

#undef U
#undef ABAR
#undef A64
#undef BB
#undef CT
#undef SST
#undef WSF
#undef U
#undef ABAR
#undef A64
#undef SST
#define MFMA16(a, b, c) __builtin_amdgcn_mfma_f32_16x16x32_bf16((a), (b), (c), 0, 0, 0)
constexpr int SSM_WREG = 16384;
#define WSF(off) ((float*)(ws + (unsigned)(off)))
#define U WSF(WS_U)
#define ABAR WSF(WS_ABAR)
#define A64 WSF(WS_A64)
#define SST WSF(WS_SST)
DI void ssm_load_u(const float* Up, LAS unsigned char* UB, int lane) {
    const f32x4* up = (const f32x4*)Up;
    const f32x4 a = up[0], b = up[1], c = up[2], d = up[3];
    *(LAS u32x4*)(UB + lane * 32) = pack8(a, b); *(LAS u32x4*)(UB + lane * 32 + 16) = pack8(c, d);
    if (lane < 2) *(LAS u32x4*)(UB + 64 * 32 + lane * 16) = (u32x4){0u, 0u, 0u, 0u};
}
DI void ssm_bu16(const LAS unsigned char* UB, LAS float* BUS, const bf16x8 (&bfr)[8], int sc, int lane) {
    const bf16x8 af = *(const LAS bf16x8*)(UB + (lane < 32 ? (sc * 16 + (lane & 15)) * 32 + (lane >> 4) * 16 : 64 * 32));
    f32x4 acc[8];
    asm volatile("s_nop 15" :: "v"(af));
#pragma unroll
    for (int j = 0; j < 8; ++j) acc[j] = MFMA16(af, bfr[j], ((f32x4){0.f, 0.f, 0.f, 0.f}));
    asm volatile("s_nop 15\n\ts_nop 15\n\ts_nop 15\n\ts_nop 15" : "+v"(acc[0]), "+v"(acc[1]), "+v"(acc[2]), "+v"(acc[3]), "+v"(acc[4]), "+v"(acc[5]), "+v"(acc[6]), "+v"(acc[7]) : "v"(af));
#pragma unroll
    for (int j = 0; j < 8; ++j)
#pragma unroll
        for (int e = 0; e < 4; ++e) BUS[(4 * (lane >> 4) + e) * 132 + 16 * j + (lane & 15)] = acc[j][e];
}
DI void ssm_load_bfr(const bf16_t* BBb, int lg, int lane, bf16x8 (&bfr)[8]) {
#pragma unroll
    for (int j = 0; j < 8; ++j) bfr[j] = *(const bf16x8*)(BBb + ((size_t)lg * 128 + 16 * j + (lane & 15)) * 16 + 8 * ((lane >> 4) & 1));
}
DI void ssm_s1_m(PP p, LAS unsigned char* lds, int l) {
    const int tid = opaque_tid(), lane = tid & 63, wid = __builtin_amdgcn_readfirstlane(tid >> 6);
    unsigned char* ws = p->ws;
    LAS unsigned char* UB = lds + wid * SSM_WREG; LAS float* BUS = (LAS float*)(UB + 2176);
    for (int it = blockIdx.x * 8 + wid; it < 4 * 32 * 32; it += gridDim.x * 8) {
        const int g = it & 31, c = (it >> 5) & 31, b = it >> 10, lg = l * 32 + g;
        const size_t tok0 = (size_t)b * 2048 + c * 64;
        ssm_load_u(U + (tok0 + lane) * 512 + g * 16, UB, lane);
        const float are = ABAR[(lg * 64 + lane) * 2], aim = ABAR[(lg * 64 + lane) * 2 + 1];
        bf16x8 bfr[8]; ssm_load_bfr((const bf16_t*)(ws + (unsigned)WS_BBB), lg, lane, bfr);
        asm volatile("s_waitcnt lgkmcnt(0)" ::: "memory");
        f32x2 hh = {0.f, 0.f}; const f32x2 a1 = {are, are}, a2 = {-aim, aim};
        for (int sc = 0; sc < 4; ++sc) {
            ssm_bu16(UB, BUS, bfr, sc, lane);
            asm volatile("s_waitcnt lgkmcnt(0)" ::: "memory");
#pragma unroll 4
            for (int t16 = 0; t16 < 16; ++t16) { const f32x2 bu = *(const LAS f32x2*)(BUS + t16 * 132 + 2 * lane); hh = a1 * hh + a2 * (f32x2){hh[1], hh[0]} + bu; }
            asm volatile("s_waitcnt lgkmcnt(0)" ::: "memory");
        }
        *(f32x2*)(SST + ((size_t)((b * 32 + c) * 32 + g) * 64 + lane) * 2) = hh;
    }
}
DI void ssm_s3_m(PP p, LAS unsigned char* lds, int l) {
    const int tid = opaque_tid(), lane = tid & 63, wid = __builtin_amdgcn_readfirstlane(tid >> 6);
    unsigned char* ws = p->ws;
    const float* dskip = p->in[13] + l * 512; bf16_t* YG = (bf16_t*)(ws + (unsigned)WS_YG);
    LAS unsigned char* UB = lds + wid * SSM_WREG; LAS float* BUS = (LAS float*)(UB + 2176); LAS unsigned char* HB = (LAS unsigned char*)(BUS + 16 * 132);
    for (int it = blockIdx.x * 8 + wid; it < 4 * 32 * 32; it += gridDim.x * 8) {
        const int g = it & 31, c = (it >> 5) & 31, b = it >> 10, lg = l * 32 + g;
        const size_t tok0 = (size_t)b * 2048 + c * 64;
        ssm_load_u(U + (tok0 + lane) * 512 + g * 16, UB, lane);
        const float are = ABAR[(lg * 64 + lane) * 2], aim = ABAR[(lg * 64 + lane) * 2 + 1];
        const float a6re = A64[(lg * 64 + lane) * 2], a6im = A64[(lg * 64 + lane) * 2 + 1];
        bf16x8 bfr[8]; ssm_load_bfr((const bf16_t*)(ws + (unsigned)WS_BBB), lg, lane, bfr);
        bf16x8 cfr[4];
#pragma unroll
        for (int kk = 0; kk < 4; ++kk) cfr[kk] = *(const bf16x8*)((const bf16_t*)(ws + (unsigned)WS_CTB) + ((size_t)lg * 16 + (lane & 15)) * 128 + 32 * kk + 8 * (lane >> 4));
        const float dsk = dskip[g * 16 + (lane & 15)];
        f32x2 hh = {0.f, 0.f}; const f32x2 a1 = {are, are}, a2 = {-aim, aim};
        { const f32x2* sp = (const f32x2*)SST + (size_t)(b * 32 * 32 + g) * 64 + lane;
          const f32x2 c1 = {a6re, a6re}, c2 = {-a6im, a6im};
          f32x2 sv[31];
#pragma unroll
          for (int cp_ = 0; cp_ < 31; ++cp_) sv[cp_] = cp_ < c ? sp[(size_t)cp_ * 32 * 64] : (f32x2){0.f, 0.f};
#pragma unroll
          for (int cp_ = 0; cp_ < 31; ++cp_) if (cp_ < c) hh = c1 * hh + c2 * (f32x2){hh[1], hh[0]} + sv[cp_]; }
        asm volatile("s_waitcnt lgkmcnt(0)" ::: "memory");
        for (int sc = 0; sc < 4; ++sc) {
            ssm_bu16(UB, BUS, bfr, sc, lane);
            asm volatile("s_waitcnt lgkmcnt(0)" ::: "memory");
#pragma unroll 4
            for (int t16 = 0; t16 < 16; ++t16) {
                const f32x2 bu = *(const LAS f32x2*)(BUS + t16 * 132 + 2 * lane);
                hh = a1 * hh + a2 * (f32x2){hh[1], hh[0]} + bu;
                *(LAS unsigned*)(HB + t16 * 272 + 4 * lane) = cvtpk(hh[0], hh[1]);
            }
            asm volatile("s_waitcnt lgkmcnt(0)" ::: "memory");
            f32x4 acc = {0.f, 0.f, 0.f, 0.f};
            bf16x8 hf[4];
#pragma unroll
            for (int kk = 0; kk < 4; ++kk) hf[kk] = *(const LAS bf16x8*)(HB + (lane & 15) * 272 + (32 * kk + 8 * (lane >> 4)) * 2);
            asm volatile("s_waitcnt lgkmcnt(0)\n\ts_nop 15" : "+v"(hf[0]), "+v"(hf[1]), "+v"(hf[2]), "+v"(hf[3]) :: "memory");
#pragma unroll
            for (int kk = 0; kk < 4; ++kk) acc = MFMA16(hf[kk], cfr[kk], acc);
            asm volatile("s_nop 15\n\ts_nop 15\n\ts_nop 15\n\ts_nop 15" : "+v"(acc) : "v"(hf[0]), "v"(hf[1]), "v"(hf[2]), "v"(hf[3]));
#pragma unroll
            for (int j = 0; j < 4; ++j) {
                const int t = sc * 16 + 4 * (lane >> 4) + j;
                float y = acc[j] + dsk * bf2f(*(const LAS bf16_t*)(UB + t * 32 + (lane & 15) * 2));
                const float z = 0.7978845608028654f * (y + 0.044715f * y * y * y);
                const float th = 1.f - 2.f * __builtin_amdgcn_rcpf(1.f + fexp2(2.f * LOG2E * z));
                y = 0.5f * y * (1.f + th);
                YG[(tok0 + t) * 512 + g * 16 + (lane & 15)] = (bf16_t)(cvtpk(y, 0.f) & 0xffffu);
            }
            asm volatile("s_waitcnt lgkmcnt(0)" ::: "memory");
        }
    }
}
#undef MFMA16
#undef WSF
#undef U
#undef ABAR
#undef A64
#undef SST
DI void dil_combine(PP p, int l, int wblk, int nblk) {
    const int tid = opaque_tid(), lane = tid & 63, wid = __builtin_amdgcn_readfirstlane(tid >> 6);
    unsigned char* ws = p->ws;
    const bf16_t* DP = (const bf16_t*)(ws + WS_DP); const float* DLSE = (const float*)(ws + WS_DLSE); bf16_t* YCAT = (bf16_t*)(ws + WS_YCAT);
    ssacc_t* ssd = (ssacc_t*)(ws + WS_SS) + (size_t)(SS_DIL + l) * M_;
    for (int m = wblk * 8 + wid; m < M_; m += nblk * 8) {
        const int hd = lane >> 3;
        const float l0 = DLSE[((size_t)0 * M_ + m) * 8 + hd], l1 = DLSE[((size_t)1 * M_ + m) * 8 + hd], l2 = DLSE[((size_t)2 * M_ + m) * 8 + hd];
        const float mx = fmaxf(l0, fmaxf(l1, l2));
        float w0 = fexp2(l0 - mx), w1 = fexp2(l1 - mx), w2 = fexp2(l2 - mx); const float inv = 1.f / (w0 + w1 + w2); w0 *= inv; w1 *= inv; w2 *= inv;
        const u32x4 q0 = *(const u32x4*)(DP + ((size_t)0 * M_ + m) * 512 + lane * 8), q1 = *(const u32x4*)(DP + ((size_t)1 * M_ + m) * 512 + lane * 8), q2 = *(const u32x4*)(DP + ((size_t)2 * M_ + m) * 512 + lane * 8);
        f32x4 a, bq;
#pragma unroll
        for (int e = 0; e < 4; ++e) {
            const unsigned u0 = q0[e], u1 = q1[e], u2 = q2[e];
            const float lo = __builtin_bit_cast(float, u0 << 16) * w0 + __builtin_bit_cast(float, u1 << 16) * w1 + __builtin_bit_cast(float, u2 << 16) * w2;
            const float hi = __builtin_bit_cast(float, u0 & 0xffff0000u) * w0 + __builtin_bit_cast(float, u1 & 0xffff0000u) * w1 + __builtin_bit_cast(float, u2 & 0xffff0000u) * w2;
            if (e < 2) { a[2 * e] = lo; a[2 * e + 1] = hi; } else { bq[2 * (e - 2)] = lo; bq[2 * (e - 2) + 1] = hi; }
        }
        *(u32x4*)(YCAT + (size_t)m * 2048 + 1536 + lane * 8) = pack8(a, bq);
        const float s = wave_sum(sq8(a, bq)); if (lane == 0) ss_set(ssd + m, s);
    }
}

DI void final_norm(PP p) {
    const int tid = opaque_tid(), lane = tid & 63, wid = __builtin_amdgcn_readfirstlane(tid >> 6);
    const float* X = (const float*)(p->ws + WS_X); const ssacc_t* ss = (const ssacc_t*)(p->ws + WS_SS) + (size_t)(SS_X + 4) * M_; const float* g = p->in[25];
    for (int m = blockIdx.x * 8 + wid; m < M_; m += gridDim.x * 8) {
        const float rs = rsqrtf(ss_get(ss + m) * (1.f / 2048.f) + EPS_);
#pragma unroll
        for (int j = 0; j < 8; ++j) { const int c = j * 256 + lane * 4; const f32x4 v = *(const f32x4*)(X + (size_t)m * 2048 + c), gg = *(const f32x4*)(g + c); *(f32x4*)(p->out + (size_t)m * 2048 + c) = v * rs * gg; }
    }
}


#define XB_TMO      128
#define XB_XCNT(j)  (256  + 64 * (j))
#define XB_XSUB(j)  (1280 + 64 * (j))
#define XB_XGEN(j)  (2304 + 64 * (j))
#define XB_TOP      3328
#define XB_TOPGEN   3392
#define XCD_BAR_WORDS 3456
#define XB_SPIN_CAP (1u << 22)
DI unsigned xb_ld(unsigned* p)              { return __hip_atomic_load(p, __ATOMIC_RELAXED, __HIP_MEMORY_SCOPE_AGENT); }
DI unsigned xb_add(unsigned* p, unsigned v) { return __hip_atomic_fetch_add(p, v, __ATOMIC_RELAXED, __HIP_MEMORY_SCOPE_AGENT); }
DI unsigned xb_xcc_id() { return (unsigned)__builtin_amdgcn_s_getreg((3 << 11) | 20) & 0xFu; }
#define XB_SPIN(cond, bar) do { unsigned _sp = 0; while (cond) { __builtin_amdgcn_s_sleep(1); \
    if ((++_sp & 255u) == 0u) { if (xb_ld(&(bar)[XB_TMO])) break; if (_sp > XB_SPIN_CAP) { atomicAdd(&(bar)[XB_TMO], 1u); break; } } } } while (0)
struct XcdBarrier { unsigned* bar; unsigned x; volatile LAS unsigned* st; };
DI XcdBarrier xcd_barrier_post(unsigned* bar, volatile LAS unsigned* st) {
    XcdBarrier b; b.bar = bar; b.x = xb_xcc_id(); b.st = st;
    if (threadIdx.x == 0) (void)xb_add(&bar[XB_XCNT(b.x)], 1u);
    return b;
}
DI void xcd_barrier_complete(unsigned* bar, unsigned x, unsigned& nloc, unsigned& nx) {
    const unsigned G = gridDim.x * gridDim.y * gridDim.z;
    unsigned sum, cnt, mine, sp = 0u;
    for (;;) {
        sum = 0u; cnt = 0u; mine = 0u;
#pragma unroll
        for (unsigned j = 0; j < 16; ++j) { const unsigned c = xb_ld(&bar[XB_XCNT(j)]); sum += c; cnt += (c > 0u) ? 1u : 0u; mine = (j == x) ? c : mine; }
        if (sum == G) break;
        __builtin_amdgcn_s_sleep(1);
        if ((++sp & 255u) == 0u) { if (xb_ld(&bar[XB_TMO])) break; if (sp > XB_SPIN_CAP) { atomicAdd(&bar[XB_TMO], 1u); break; } }
    }
    nloc = mine > 0u ? mine : 1u; nx = cnt > 0u ? cnt : 1u;
}
DI void xcd_barrier(const XcdBarrier& b) {
    asm volatile("s_waitcnt vmcnt(0)" ::: "memory");
    __syncthreads();
    if (threadIdx.x == 0) {
        unsigned* bar = b.bar;
        __builtin_amdgcn_s_waitcnt(0);
        unsigned nloc = b.st[0], nx = b.st[1];
        if (nloc == 0u) { xcd_barrier_complete(bar, b.x, nloc, nx); b.st[0] = nloc; b.st[1] = nx; }
        const unsigned old = xb_add(&bar[XB_XSUB(b.x)], 1u);
        const unsigned gen = old / nloc;
        if (old + 1u == (gen + 1u) * nloc) {
            __builtin_amdgcn_fence(__ATOMIC_RELEASE, "agent");
            asm volatile("s_waitcnt vmcnt(0)" ::: "memory");
            const unsigned og = xb_add(&bar[XB_TOP], 1u);
            const unsigned tg = og / nx;
            if (og + 1u == (tg + 1u) * nx) xb_add(&bar[XB_TOPGEN], 1u);
            else XB_SPIN(xb_ld(&bar[XB_TOPGEN]) == tg, bar);
            __builtin_amdgcn_fence(__ATOMIC_ACQUIRE, "agent");
            xb_add(&bar[XB_XGEN(b.x)], 1u);
            asm volatile("s_waitcnt vmcnt(0)" ::: "memory");
        } else {
            XB_SPIN(xb_ld(&bar[XB_XGEN(b.x)]) == gen, bar);
            __builtin_amdgcn_fence(__ATOMIC_ACQUIRE, "agent");
            asm volatile("s_waitcnt vmcnt(0)" ::: "memory");
        }
    }
    __syncthreads();
}
__global__ void __launch_bounds__(512, 2) hymba_fwd(Params p_unused) {
    extern __shared__ __attribute__((aligned(16))) unsigned char lds_raw[];
    LAS unsigned char* lds = (LAS unsigned char*)lds_raw;
    cg::grid_group grid = cg::this_grid();
#define SSP(ws, idx, l) ((ssacc_t*)((ws) + WS_SS) + (size_t)((idx) + (l)) * M_)
    volatile LAS unsigned* bst = (volatile LAS unsigned*)(lds + LDS_BYTES - 256);
    if (threadIdx.x < 2) bst[threadIdx.x] = 0u;
    __syncthreads();
    XcdBarrier xbar = xcd_barrier_post((unsigned*)(getpp()->ws + WS_CTL), bst);
#define GRID_SYNC() xcd_barrier(xbar)
#define TAIL_CONVERT(NWG, HALF) do { if (l + 1 < DEPTH_) { const int G_ = (int)gridDim.x, rem_ = (NWG) % G_; const int first_ = rem_ == 0 ? 0 : rem_, nb_ = G_ - first_; \
        if ((int)blockIdx.x >= first_) convert_weights(getpp(), lds, l + 1, (((int)blockIdx.x - first_) * 8 + (int)(threadIdx.x >> 6)) * 2 + (HALF), nb_ * 8 * 2); } } while (0)
#if !defined(NO_PRO)
    prologue(getpp(), lds);
    convert_weights(getpp(), lds, 0, blockIdx.x * 8 + (threadIdx.x >> 6), gridDim.x * 8);
#endif
    grid.sync();

    for (int l = 0; l < DEPTH_; ++l) {
#if GEMM_MASK & 1
        { PP p = getpp(); unsigned char* ws = p->ws; const unsigned char* wl = ws + WS_W + (size_t)l * W_LAYER;
          EpiInProj E{ws, l};
          run_gemm(lds, (const bf16_t*)(ws + WS_XB), (const bf16_t*)(wl + W_IN), NIN_, 2048, E); }
#endif
        TAIL_CONVERT(384, 0);
        GRID_SYNC();
#if GEMM_MASK & 2
        { PP p = getpp(); unsigned char* ws = p->ws; const unsigned char* wl = ws + WS_W + (size_t)l * W_LAYER;
          EpiQUp E{SSP(ws, SS_Q, l), (const float*)(ws + WS_ROPE), (bf16_t*)(ws + WS_Q)}; for (int rep = 0; rep < ((DUP_GEMM & 1) ? 2 : 1); ++rep) run_gemm(lds, (const bf16_t*)(ws + WS_CQ), (const bf16_t*)(wl + W_UQ), 1536, 512, E); }
#endif
#if GEMM_MASK & 4
        { PP p = getpp(); unsigned char* ws = p->ws; const unsigned char* wl = ws + WS_W + (size_t)l * W_LAYER;
          EpiKvUp E{SSP(ws, SS_KV, l), (bf16_t*)(ws + WS_KV)}; for (int rep = 0; rep < ((DUP_GEMM & 1) ? 2 : 1); ++rep) run_gemm(lds, (const bf16_t*)(ws + WS_CKV), (const bf16_t*)(wl + W_UKV), 2048, 256, E); }
#endif
        { PP p = getpp(); unsigned char* ws = p->ws;
          AttnPtrs AP{ws, l};
          for (int it = blockIdx.x; it < 1536; it += gridDim.x) {
              const int pat = it >> 9, b = (it >> 7) & 3, hd = (it >> 4) & 7, x = it & 15;
              const int dmul = pat == 0 ? 1 : (pat == 1 ? 4 : 16), nper = 16 / dmul, r0 = x / nper, nbk = x % nper;
#if !defined(NO_ATT1)
              attn_unit<1>(lds, AP, b, hd, nbk * 128, dmul, r0, pat, nbk > 0 ? nbk - 1 : 0, nbk + 1);
              if (DUP_MIX & 1) attn_unit<1>(lds, AP, b, hd, nbk * 128, dmul, r0, pat, nbk > 0 ? nbk - 1 : 0, nbk + 1);
#endif
          }
          __syncthreads(); }
#if !defined(NO_SSM)
        ssm_s1_m(getpp(), lds, l);
        if (DUP_MIX & 2) ssm_s1(getpp(), lds, l);
#endif
        GRID_SYNC();
#if !defined(NO_SSM)
        ssm_s3_m(getpp(), lds, l);
        if (DUP_MIX & 8) ssm_s3(getpp(), lds, l);
#endif
        __syncthreads();
        { PP p = getpp(); unsigned char* ws = p->ws;
          AttnPtrs AP{ws, l};
          LAS int* tk = (LAS int*)(lds + LDS_BYTES - 128);
          if (threadIdx.x == 0) {
              unsigned* ctl = (unsigned*)(ws + WS_CTL); int pr0 = -1;
              if (gridDim.x == 256) { bool uni = true;
                  for (int jx = 0; jx < 16; ++jx) uni = uni && (xb_ld(&ctl[XB_XCNT(jx)]) == (jx < 8 ? 32u : 0u));
                  if (uni) { const unsigned xcc = xb_xcc_id(); const unsigned tkt = xb_add(&ctl[8192 + l * 16 + xcc], 1u); if (xcc < 8 && tkt < 32) pr0 = (int)((xcc * 4 + (tkt >> 3)) * 8 + (tkt & 7)); } }
              *tk = pr0;
          }
          __syncthreads();
          const int prx = *tk;
          for (int pr = blockIdx.x; pr < 256; pr += gridDim.x) {
              const int pq = prx >= 0 ? prx : pr;
              const int bh = pq >> 3, j = pq & 7, b = bh >> 3, hd = bh & 7;
#if !defined(NO_ATT0)
              mla_unit<true>(lds, AP, b, hd, j);
              mla_unit<true>(lds, AP, b, hd, 15 - j);
              if (DUP_MIX & 16) { mla_unit<false>(lds, AP, b, hd, j); mla_unit<false>(lds, AP, b, hd, 15 - j); }
#endif
          }
          __syncthreads(); }
        GRID_SYNC();
#if GEMM_MASK & 8
        { PP p = getpp(); unsigned char* ws = p->ws; const unsigned char* wl = ws + WS_W + (size_t)l * W_LAYER;
          EpiGlu E{p->in[16] + l * 1024, (bf16_t*)(ws + WS_YCAT), SSP(ws, SS_SSM, l)}; run_gemm(lds, (const bf16_t*)(ws + WS_YG), (const bf16_t*)(wl + W_GLU), 1024, 512, E); }
#endif
        { const int G_ = (int)gridDim.x, first_ = G_ > 128 ? 128 : 0; if ((int)blockIdx.x >= first_) dil_combine(getpp(), l, (int)blockIdx.x - first_, G_ - first_); }
        GRID_SYNC();
#if GEMM_MASK & 16
        { PP p = getpp(); unsigned char* ws = p->ws; const unsigned char* wl = ws + WS_W + (size_t)l * W_LAYER;
          const ssacc_t *ss_ssm = SSP(ws, SS_SSM, l), *ss_mla = SSP(ws, SS_MLA, l), *ss_dil = SSP(ws, SS_DIL, l);
          LAS float* FT = (LAS float*)(lds + 131072);
          { pg8::StaticOrder S; S.init(M_, 2048, (int)gridDim.x, (int)blockIdx.x);
            const int ui = threadIdx.x >> 8, rr = threadIdx.x & 255; Unit u;
            if (S.next(ui, u)) { const int row = u.pm * 256 + rr; const float rm = rsqrtf(ss_get(ss_mla + row) * (1.f / 1024.f) + EPS_), rsm = rsqrtf(ss_get(ss_ssm + row) * (1.f / 512.f) + EPS_), rd = rsqrtf(ss_get(ss_dil + row) * (1.f / 512.f) + EPS_);
                FT[(ui * 2 + 0) * 256 + rr] = rsm / rm; FT[(ui * 2 + 1) * 256 + rr] = rm / rd; }
            __syncthreads(); }
          float* X = (float*)(ws + WS_X);
          EpiWo E{ws, l, l == 0 ? p->in[0] : X, FT}; run_gemm(lds, (const bf16_t*)(ws + WS_YCAT), (const bf16_t*)(wl + W_O), 2048, 2048, E); }
#endif
        GRID_SYNC();
#if GEMM_MASK & 32
        { PP p = getpp(); unsigned char* ws = p->ws; const unsigned char* wl = ws + WS_W + (size_t)l * W_LAYER;
          EpiGateUp E{SSP(ws, SS_X1, l), (bf16_t*)(ws + WS_HM)}; for (int rep = 0; rep < ((DUP_GEMM & 2) ? 2 : 1); ++rep) run_gemm(lds, (const bf16_t*)(ws + WS_XB), (const bf16_t*)(wl + W_GU), 2 * DFF_, 2048, E); }
#endif
        TAIL_CONVERT(1408, 1);
        GRID_SYNC();
#if GEMM_MASK & 64
        { PP p = getpp(); unsigned char* ws = p->ws; const unsigned char* wl = ws + WS_W + (size_t)l * W_LAYER;
          EpiDown E{(float*)(ws + WS_X), (bf16_t*)(ws + WS_XB), SSP(ws, SS_X, l + 1)}; run_gemm(lds, (const bf16_t*)(ws + WS_HM), (const bf16_t*)(wl + W_DN), 2048, DFF_, E); }
#endif
        GRID_SYNC();
    }
    final_norm(getpp());
}

extern "C" void kernel_launch(void* const* d_in, const int* in_sizes, int n_in, void* d_out, int out_size, void* d_ws, size_t ws_size, hipStream_t stream) {
    static int grid = 0;
    if (grid == 0) {
        if (n_in != 26 || out_size != M_ * D_ || ws_size < WS_END) { fprintf(stderr, "kernel_launch: unexpected shapes: n_in %d out %d ws %zu (need %zu)\n", n_in, out_size, ws_size, (size_t)WS_END); grid = -1; return; }
        int dev = 0, cus = 0, per_cu = 0;
        hipGetDevice(&dev); hipDeviceGetAttribute(&cus, hipDeviceAttributeMultiprocessorCount, dev);
        if (hipFuncSetAttribute((const void*)hymba_fwd, hipFuncAttributeMaxDynamicSharedMemorySize, LDS_BYTES) != hipSuccess) { fprintf(stderr, "kernel_launch: hipFuncSetAttribute failed\n"); grid = -1; return; }
        if (hipOccupancyMaxActiveBlocksPerMultiprocessor(&per_cu, (const void*)hymba_fwd, 512, LDS_BYTES) != hipSuccess || per_cu < 1) { fprintf(stderr, "kernel_launch: occupancy query gave %d\n", per_cu); per_cu = 1; }
        (void)hipGetLastError();
        grid = cus * 1;
        fprintf(stderr, "kernel_launch: grid %d (per_cu %d)\n", grid, per_cu);
    }
    if (grid < 0) return;
    if (hipMemsetAsync((char*)d_ws + WS_CTL, 0, 65536, stream) != hipSuccess) { fprintf(stderr, "kernel_launch: memset failed\n"); return; }
    Params p{};
    for (int i = 0; i < 26; ++i) p.in[i] = (const float*)d_in[i];
    p.out = (float*)d_out; p.ws = (unsigned char*)d_ws;
    void* args[] = {&p};
    hipError_t e = hipLaunchCooperativeKernel((const void*)hymba_fwd, dim3(grid), dim3(512), args, LDS_BYTES, stream);
    if (e != hipSuccess) fprintf(stderr, "cooperative launch failed: %s (grid %d)\n", hipGetErrorString(e), grid);
}
```

```cpp
#include <hip/hip_runtime.h>
#include <hip/hip_cooperative_groups.h>
#include <cstdio>
#include <cstdint>
namespace cg = cooperative_groups;
#ifndef DUP_MIX
#define DUP_MIX 0
#endif
#ifndef DUP_GEMM
#define DUP_GEMM 0
#endif
#ifndef GEMM_MASK
#define GEMM_MASK 127
#endif

#define LAS __attribute__((address_space(3)))
typedef unsigned short bf16_t;
typedef short bf16x8 __attribute__((ext_vector_type(8)));
typedef short s16x4 __attribute__((ext_vector_type(4)));
typedef float f32x4 __attribute__((ext_vector_type(4)));
typedef float f32x2 __attribute__((ext_vector_type(2)));
typedef float f32x16 __attribute__((ext_vector_type(16)));
typedef unsigned u32x4 __attribute__((ext_vector_type(4)));
typedef unsigned u32x2 __attribute__((ext_vector_type(2)));
typedef __bf16 bf16x2_t __attribute__((ext_vector_type(2)));
#define DI __device__ __forceinline__

constexpr int M_ = 8192, D_ = 2048, SEQ_ = 2048, DEPTH_ = 4;
constexpr int NIN_ = 3072  , DFF_ = 5632;
constexpr float EPS_ = 1e-6f;
constexpr float LOG2E = 1.4426950408889634f;
constexpr float QSCALE_MLA = 0.07216878364870322f * LOG2E;
constexpr float QSCALE_DIL = 0.125f * LOG2E;

constexpr size_t MiB = 1u << 20;
constexpr size_t WS_CTL = 0;
constexpr size_t WS_ROPE = 1 * MiB;
constexpr size_t WS_ABAR = WS_ROPE + 512 * 1024;
constexpr size_t WS_A64 = WS_ABAR + 64 * 1024;
constexpr size_t WS_BB = 2 * MiB;
constexpr size_t WS_CT = 3 * MiB;
constexpr size_t WS_SST = 6 * MiB;
constexpr size_t WS_W = 8 * MiB;
constexpr size_t W_IN = 0, W_UQ = 12 * MiB, W_UKV = W_UQ + 3 * MiB / 2, W_GLU = W_UKV + 1 * MiB, W_O = W_GLU + 1 * MiB, W_GU = W_O + 8 * MiB, W_DN = W_GU + 44 * MiB, W_LAYER = W_DN + 22 * MiB;
constexpr size_t WS_X = WS_W + 4 * W_LAYER;
constexpr size_t WS_XB = WS_X + 64 * MiB;
constexpr size_t WS_MIX = WS_XB + 32 * MiB;
constexpr size_t WS_CQ = WS_MIX, WS_CKV = WS_CQ + 8 * MiB, WS_KPE = WS_CKV + 4 * MiB, WS_U = WS_KPE + 1 * MiB, WS_QD = WS_U + 16 * MiB, WS_KD = WS_QD + 8 * MiB, WS_VD = WS_KD + 8 * MiB,
                 WS_Q = WS_VD + 8 * MiB, WS_KV = WS_Q + 24 * MiB, WS_DP = WS_KV + 32 * MiB, WS_DLSE = WS_DP + 48 * MiB, WS_YCAT = WS_DLSE + 1 * MiB, WS_YG = WS_YCAT + 32 * MiB, WS_MIXEND = WS_YG + 8 * MiB;
constexpr size_t WS_HM = WS_MIX;
constexpr size_t WS_BBB = WS_MIXEND;
constexpr size_t WS_CTB = WS_BBB + 512 * 1024;
constexpr size_t WS_SS = WS_CTB + 512 * 1024;
constexpr size_t WS_END = WS_SS + 2 * MiB;
static_assert(WS_HM + (size_t)M_ * DFF_ * 2 <= WS_MIXEND, "HM overlay");
constexpr int SS_X = 0  , SS_Q = 5, SS_KV = 9, SS_SSM = 13, SS_MLA = 17, SS_DIL = 21, SS_X1 = 25, SS_N = 29;

constexpr int LDS_BYTES = 147456;

DI int opaque_tid() { int t = threadIdx.x; asm volatile("" : "+v"(t)); return t; }
typedef unsigned long long ssacc_t;
DI void ss_add(ssacc_t* p, float v) { atomicAdd(p, (ssacc_t)__float2ull_rn(v * 4294967296.f)); }
DI void ss_set(ssacc_t* p, float v) { *p = (ssacc_t)__float2ull_rn(v * 4294967296.f); }
DI float ss_get(const ssacc_t* p) { const ssacc_t v = *p; return (float)(unsigned)(v >> 32) + (float)(unsigned)(v & 0xffffffffull) * 2.3283064365386963e-10f; }
DI unsigned cvtpk(float lo, float hi) { f32x2 v = {lo, hi}; bf16x2_t b = __builtin_convertvector(v, bf16x2_t); return __builtin_bit_cast(unsigned, b); }
DI float bf2f(bf16_t b) { return __builtin_bit_cast(float, (unsigned)b << 16); }
DI float fexp2(float x) { return __builtin_amdgcn_exp2f(x); }
DI float sigmoidf_(float x) { return __builtin_amdgcn_rcpf(1.f + fexp2(-LOG2E * x)); }

namespace pg8 {
constexpr int BM = 256, BK = 64, HALF = 128, HTB = HALF * BK * 2, STAGE_BYTES = 8 * HTB, NXCD = 8, WGM = 8;
__host__ __device__ __forceinline__ int lds_byte(int r, int c) { const int st = (r >> 4) * 2 + (c >> 5), rr = r & 15, cc = c & 31, ob = rr * 64 + cc * 2; return st * 1024 + (ob ^ (((ob >> 9) & 1) << 5)); }
__host__ __device__ __forceinline__ void stage_rc(int b, int& R, int& C) { const int st = b / 1024, sb = b % 1024, swz = sb ^ (((sb >> 9) & 1) << 5); R = (st >> 1) * 16 + swz / 64; C = (st & 1) * 32 + (swz % 64) / 2; }
__host__ __device__ __forceinline__ int perm32(int rho) { const int n = rho >> 4, i = rho & 15; return 8 * (i >> 2) + 4 * n + (i & 3); }
struct Unit { int pm, pn; };
struct Gemm { const bf16_t* A; const bf16_t* Bt; int M, N, K; };
struct StaticOrder {
    int nM, nN, nwg, G, c;
    __host__ __device__ __forceinline__ void init(int M, int N, int G_, int c_) { nM = M / BM; nN = N / BM; nwg = nM * nN; G = G_; c = c_; }
    __host__ __device__ __forceinline__ bool next(int i, Unit& u) const {
        const long L = (long)i * G + c; if (L >= nwg) return false;
        int wgid = (int)L; { const int q = nwg / NXCD, r = nwg % NXCD, xcd = wgid % NXCD, off = wgid / NXCD; wgid = (xcd < r ? xcd * (q + 1) : r * (q + 1) + (xcd - r) * q) + off; }
        const int nig = WGM * nN, gid = wgid / nig, fm = gid * WGM, gsz = (nM - fm) < WGM ? (nM - fm) : WGM;
        u.pm = fm + ((wgid % nig) % gsz); u.pn = (wgid % nig) / gsz; return true;
    }
};
template <class Epi, class Sched, bool ALIGN_EPI, bool SP2>
__device__ __forceinline__ void gemm_phase(LAS unsigned char* lds, const Gemm g, const Sched& S, const Epi& E) {
    const int tid = opaque_tid(), wid = __builtin_amdgcn_readfirstlane(tid >> 6), lane = tid & 63, wr = wid >> 2, wc = wid & 3, fr = lane & 15, fq = lane >> 4;
    int K = g.K; asm volatile("" : "+s"(K)); const int nt = K / BK;
    unsigned voffA, voffB;
    { int R, C; stage_rc(tid * 16, R, C); const int Rb = Epi::PERM ? ((R & ~31) + perm32(R & 31)) : R;
      voffA = (unsigned)(R * K + C) * 2u; voffB = (unsigned)(Rb * K + C) * 2u; }
    const size_t rdelta = (size_t)64 * K * 2;
    const size_t kstep = (size_t)(BK * 2);
    const size_t hstep = (size_t)HALF * K * 2;
    const size_t tstep = 2 * hstep;
    const unsigned ldsw = (unsigned)wid * 1024u;
    const int aoff = lds_byte(wr * 64 + fr, fq * 8), boff = lds_byte(wc * 32 + fr, fq * 8);
#define PG8_SA(b, h) (((b) * 2 + (h)) * HTB)
#define PG8_SB(b, h) ((4 + (b) * 2 + (h)) * HTB)
#define PG8_STAGE(bufoff, gbase, voff) do { _Pragma("unroll") for (int _i = 0; _i < 2; ++_i) \
        __builtin_amdgcn_global_load_lds((const unsigned*)((const char*)(gbase) + _i * rdelta + (voff)), (LAS unsigned*)(lds + (bufoff) + ldsw + _i * 8192), 16, 0, 0); } while (0)
#define PG8_LDA(dst, b, h) do { _Pragma("unroll") for (int m = 0; m < 4; ++m) _Pragma("unroll") for (int k = 0; k < 2; ++k) dst[m][k] = *(const LAS bf16x8*)(lds + PG8_SA(b, h) + aoff + m * 2048 + k * 1024); } while (0)
#define PG8_LDB(dst, b, h) do { _Pragma("unroll") for (int n = 0; n < 2; ++n) _Pragma("unroll") for (int k = 0; k < 2; ++k) dst[n][k] = *(const LAS bf16x8*)(lds + PG8_SB(b, h) + boff + n * 2048 + k * 1024); } while (0)
#define PG8_MMA(ai, bj, At, Bt) do { __builtin_amdgcn_s_setprio(1); _Pragma("unroll") for (int m = 0; m < 4; ++m) _Pragma("unroll") for (int n = 0; n < 2; ++n) _Pragma("unroll") for (int k = 0; k < 2; ++k) \
        acc[ai][bj][m][n] = __builtin_amdgcn_mfma_f32_16x16x32_bf16(Bt[n][k], At[m][k], acc[ai][bj][m][n], 0, 0, 0); __builtin_amdgcn_s_setprio(0); } while (0)
#define PG8_WAIT_V(n) asm volatile("s_waitcnt vmcnt(" #n ")" ::: "memory")
#define PG8_WAIT_L(n) asm volatile("s_waitcnt lgkmcnt(" #n ")" ::: "memory")
#define PG8_BAR __builtin_amdgcn_s_barrier()
#define PG8_SCHED __builtin_amdgcn_sched_barrier(0)
    Unit cur, nxt; int ui = 0;
    if (!S.next(0, cur)) return;
    f32x4 acc[2][2][4][2];
#pragma unroll
    for (int a = 0; a < 2; ++a)
#pragma unroll
        for (int b = 0; b < 2; ++b)
#pragma unroll
            for (int m = 0; m < 4; ++m)
#pragma unroll
                for (int n = 0; n < 2; ++n) acc[a][b][m][n] = (f32x4){0.f, 0.f, 0.f, 0.f};
    bf16x8 At[4][2], B0[2][2], B1[2][2];
    const char* cA = (const char*)g.A + (size_t)cur.pm * tstep; const char* cB = (const char*)g.Bt + (size_t)cur.pn * tstep;
    if constexpr (SP2) {
        PG8_STAGE(PG8_SB(0, 0), cB, voffB); PG8_STAGE(PG8_SB(0, 1), cB + hstep, voffB); PG8_STAGE(PG8_SA(0, 0), cA, voffA); PG8_STAGE(PG8_SA(0, 1), cA + hstep, voffA);
        if (wr == 1) PG8_BAR;
        PG8_WAIT_V(2); PG8_BAR;
        PG8_STAGE(PG8_SB(1, 0), cB + kstep, voffB); PG8_STAGE(PG8_SA(1, 0), cA + kstep, voffA); PG8_STAGE(PG8_SB(1, 1), cB + hstep + kstep, voffB);
        PG8_WAIT_V(6); PG8_BAR;
    }
    for (;;) {
        const bool has_next = S.next(ui + 1, nxt);
        const char* nA = has_next ? (const char*)g.A + (size_t)nxt.pm * tstep : cA; const char* nB = has_next ? (const char*)g.Bt + (size_t)nxt.pn * tstep : cB;
        for (int t = 0; t < nt; t += 2) {
            if constexpr (Epi::HOOK) { if (t == Epi::T1 || t == Epi::T2) E.hook(acc, ui, t, wr, fr); }
            const bool last = (t == nt - 2);
            const char* a1 = cA + (size_t)(t + 1) * kstep;
            const char* a2 = last ? nA : cA + (size_t)(t + 2) * kstep; const char* b2 = last ? nB : cB + (size_t)(t + 2) * kstep;
            const char* a3 = a2 + kstep; const char* b3 = b2 + kstep;
            PG8_LDB(B0, 0, 0); PG8_LDB(B1, 0, 1); PG8_SCHED; PG8_LDA(At, 0, 0); PG8_STAGE(PG8_SA(1, 1), a1 + hstep, voffA);
            PG8_WAIT_V(8); PG8_WAIT_L(0); PG8_BAR; PG8_MMA(0, 0, At, B0); PG8_MMA(0, 1, At, B1); PG8_BAR; PG8_SCHED;
            PG8_LDA(At, 0, 1); PG8_STAGE(PG8_SB(0, 0), b2, voffB); PG8_STAGE(PG8_SB(0, 1), b2 + hstep, voffB); PG8_STAGE(PG8_SA(0, 0), a2, voffA);
            PG8_WAIT_V(8); PG8_WAIT_L(0); PG8_BAR; PG8_MMA(1, 0, At, B0); PG8_MMA(1, 1, At, B1); PG8_BAR; PG8_SCHED;
            PG8_LDB(B0, 1, 0); PG8_LDB(B1, 1, 1); PG8_SCHED; PG8_LDA(At, 1, 0); PG8_STAGE(PG8_SA(0, 1), a2 + hstep, voffA);
            PG8_WAIT_V(8); PG8_WAIT_L(0); PG8_BAR; PG8_MMA(0, 0, At, B0); PG8_MMA(0, 1, At, B1); PG8_BAR; PG8_SCHED;
            PG8_LDA(At, 1, 1); PG8_STAGE(PG8_SB(1, 0), b3, voffB); PG8_STAGE(PG8_SB(1, 1), b3 + hstep, voffB); PG8_STAGE(PG8_SA(1, 0), a3, voffA);
            PG8_WAIT_V(8); PG8_WAIT_L(0); PG8_BAR; PG8_MMA(1, 0, At, B0); PG8_MMA(1, 1, At, B1); PG8_BAR; PG8_SCHED;
        }
        if constexpr (ALIGN_EPI) { if (wr == 0) PG8_BAR; }
        E(acc, cur, wr, wc, fr, fq);
        if (!has_next) break;
#pragma unroll
        for (int a = 0; a < 2; ++a)
#pragma unroll
            for (int b = 0; b < 2; ++b)
#pragma unroll
                for (int m = 0; m < 4; ++m)
#pragma unroll
                    for (int n = 0; n < 2; ++n) acc[a][b][m][n] = (f32x4){0.f, 0.f, 0.f, 0.f};
        cur = nxt; cA = nA; cB = nB; ++ui;
        if constexpr (ALIGN_EPI) { if (wr == 1) PG8_BAR; }
    }
    PG8_WAIT_V(0);
    if constexpr (!ALIGN_EPI) { if (wr == 0) PG8_BAR; }
    PG8_BAR;
#undef PG8_SA
#undef PG8_SB
#undef PG8_STAGE
#undef PG8_LDA
#undef PG8_LDB
#undef PG8_MMA
#undef PG8_WAIT_V
#undef PG8_WAIT_L
#undef PG8_BAR
#undef PG8_SCHED
}
}
using pg8::Unit;
typedef f32x4 Acc[2][2][4][2];

struct Params {
    const float* in[26];
    float* out;
    unsigned char* ws;
};

typedef const __attribute__((address_space(4))) Params* PP;
DI PP getpp() { PP pp = (PP)__builtin_amdgcn_kernarg_segment_ptr(); asm volatile("" : "+s"(pp)); return pp; }
DI float quad_sum(float s) { s += __shfl_xor(s, 16); s += __shfl_xor(s, 32); return s; }
DI float sq8(const f32x4& a, const f32x4& b) { return (a[0] * a[0] + a[1] * a[1]) + (a[2] * a[2] + a[3] * a[3]) + (b[0] * b[0] + b[1] * b[1]) + (b[2] * b[2] + b[3] * b[3]); }
DI u32x4 pack8(const f32x4& a, const f32x4& b) { u32x4 w; w.x = cvtpk(a[0], a[1]); w.y = cvtpk(a[2], a[3]); w.z = cvtpk(b[0], b[1]); w.w = cvtpk(b[2], b[3]); return w; }
DI void rope8(f32x4& a, f32x4& b, const float* rope, int pos, int j0) {
    const f32x4 cs0 = *(const f32x4*)(rope + ((size_t)pos * 32 + j0) * 2), cs1 = *(const f32x4*)(rope + ((size_t)pos * 32 + j0 + 2) * 2);
    f32x4 o0, o1;
    o0[0] = a[0] * cs0[0] - a[1] * cs0[1]; o0[1] = a[1] * cs0[0] + a[0] * cs0[1];
    o0[2] = a[2] * cs0[2] - a[3] * cs0[3]; o0[3] = a[3] * cs0[2] + a[2] * cs0[3];
    o1[0] = b[0] * cs1[0] - b[1] * cs1[1]; o1[1] = b[1] * cs1[0] + b[0] * cs1[1];
    o1[2] = b[2] * cs1[2] - b[3] * cs1[3]; o1[3] = b[3] * cs1[2] + b[2] * cs1[3];
    a = o0; b = o1;
}

struct EpiInProj {
    static constexpr bool PERM = true, HOOK = false; static constexpr int T1 = -1, T2 = -1;
    unsigned char* ws; int l;
    DI void hook(Acc&, int, int, int, int) const {}
    DI void operator()(const Acc& acc, const Unit& u, int wr, int wc, int fr, int fq) const {
        const int pn = u.pn;
        const ssacc_t* ssx = (const ssacc_t*)(ws + WS_SS) + (size_t)(SS_X + l) * M_; const float* rope = (const float*)(ws + WS_ROPE);
        bf16_t *CQ = (bf16_t*)(ws + WS_CQ), *CKV = (bf16_t*)(ws + WS_CKV), *QD = (bf16_t*)(ws + WS_QD), *KD = (bf16_t*)(ws + WS_KD), *VD = (bf16_t*)(ws + WS_VD), *KPE = (bf16_t*)(ws + WS_KPE);
        float* U = (float*)(ws + WS_U); ssacc_t *ssq = (ssacc_t*)(ws + WS_SS) + (size_t)(SS_Q + l) * M_, *sskv = (ssacc_t*)(ws + WS_SS) + (size_t)(SS_KV + l) * M_;
#pragma unroll
        for (int ai = 0; ai < 2; ++ai)
#pragma unroll
            for (int m = 0; m < 4; ++m) {
                asm volatile("" ::: "memory");
                const int row = u.pm * 256 + ai * 128 + wr * 64 + m * 16 + fr;
                const float rs = rsqrtf(ss_get(ssx + row) * (1.f / 2048.f) + EPS_);
                float sq = 0.f;
#pragma unroll
                for (int bj = 0; bj < 2; ++bj) {
                    f32x4 v0 = acc[ai][bj][m][0] * rs, v1 = acc[ai][bj][m][1] * rs;
                    const int ct = bj * 128 + wc * 32 + 8 * fq;
                    if (pn <= 1) { *(u32x4*)(CQ + (size_t)row * 512 + pn * 256 + ct) = pack8(v0, v1); sq += sq8(v0, v1); }
                    else if (pn == 2) { *(u32x4*)(CKV + (size_t)row * 256 + ct) = pack8(v0, v1); sq += sq8(v0, v1); }
                    else if (pn <= 4) { float* p = U + (size_t)row * 512 + (pn - 3) * 256 + ct; *(f32x4*)p = v0; *(f32x4*)(p + 4) = v1; }
                    else if (pn <= 6) { v0 = v0 * QSCALE_DIL; v1 = v1 * QSCALE_DIL; *(u32x4*)(QD + (size_t)row * 512 + (pn - 5) * 256 + ct) = pack8(v0, v1); }
                    else if (pn <= 8) { *(u32x4*)(KD + (size_t)row * 512 + (pn - 7) * 256 + ct) = pack8(v0, v1); }
                    else if (pn <= 10) { *(u32x4*)(VD + (size_t)row * 512 + (pn - 9) * 256 + ct) = pack8(v0, v1); }
                    else { if (ct < 64) { rope8(v0, v1, rope, row & 2047, ct >> 1); *(u32x4*)(KPE + (size_t)row * 64 + ct) = pack8(v0, v1); } }
                }
                if (pn <= 2) { sq = quad_sum(sq); if (fq == 0) ss_add((pn <= 1 ? ssq : sskv) + row, sq); }
            }
    }
};
struct EpiQUp {
    static constexpr bool PERM = true, HOOK = false; static constexpr int T1 = -1, T2 = -1;
    const ssacc_t* ssq; const float* rope; bf16_t* Q;
    DI void hook(Acc&, int, int, int, int) const {}
    DI void operator()(const Acc& acc, const Unit& u, int wr, int wc, int fr, int fq) const {
#pragma unroll
        for (int ai = 0; ai < 2; ++ai)
#pragma unroll
            for (int m = 0; m < 4; ++m) {
                asm volatile("" ::: "memory");
                const int row = u.pm * 256 + ai * 128 + wr * 64 + m * 16 + fr;
                const float rs = rsqrtf(ss_get(ssq + row) * (1.f / 512.f) + EPS_) * QSCALE_MLA;
#pragma unroll
                for (int bj = 0; bj < 2; ++bj) {
                    f32x4 v0 = acc[ai][bj][m][0] * rs, v1 = acc[ai][bj][m][1] * rs;
                    const int c0 = u.pn * 256 + bj * 128 + wc * 32 + 8 * fq;
                    const int w = c0 % 192;
                    if (w >= 128) rope8(v0, v1, rope, row & 2047, (w - 128) >> 1);
                    *(u32x4*)(Q + (size_t)row * 1536 + c0) = pack8(v0, v1);
                }
            }
    }
};
struct EpiKvUp {
    static constexpr bool PERM = true, HOOK = false; static constexpr int T1 = -1, T2 = -1;
    const ssacc_t* sskv; bf16_t* KV;
    DI void hook(Acc&, int, int, int, int) const {}
    DI void operator()(const Acc& acc, const Unit& u, int wr, int wc, int fr, int fq) const {
#pragma unroll
        for (int ai = 0; ai < 2; ++ai)
#pragma unroll
            for (int m = 0; m < 4; ++m) {
                asm volatile("" ::: "memory");
                const int row = u.pm * 256 + ai * 128 + wr * 64 + m * 16 + fr;
                const float rs = rsqrtf(ss_get(sskv + row) * (1.f / 256.f) + EPS_);
#pragma unroll
                for (int bj = 0; bj < 2; ++bj) {
                    const f32x4 v0 = acc[ai][bj][m][0] * rs, v1 = acc[ai][bj][m][1] * rs;
                    const int c0 = u.pn * 256 + bj * 128 + wc * 32 + 8 * fq;
                    *(u32x4*)(KV + (size_t)row * 2048 + c0) = pack8(v0, v1);
                }
            }
    }
};
struct EpiGlu {
    static constexpr bool PERM = true, HOOK = false; static constexpr int T1 = -1, T2 = -1;
    const float* bglu; bf16_t* YCAT; ssacc_t* ss;
    DI void hook(Acc&, int, int, int, int) const {}
    DI void operator()(const Acc& acc, const Unit& u, int wr, int wc, int fr, int fq) const {
#pragma unroll
        for (int ai = 0; ai < 2; ++ai)
#pragma unroll
            for (int m = 0; m < 4; ++m) {
                asm volatile("" ::: "memory");
                const int row = u.pm * 256 + ai * 128 + wr * 64 + m * 16 + fr;
                float sq = 0.f;
#pragma unroll
                for (int bj = 0; bj < 2; ++bj) {
                    const f32x4 v0 = acc[ai][bj][m][0], v1 = acc[ai][bj][m][1];
                    const int i0 = (u.pn * 256 + bj * 128 + wc * 32 + 8 * fq) >> 1;
                    const f32x4 b1 = *(const f32x4*)(bglu + i0), b2 = *(const f32x4*)(bglu + 512 + i0);
                    const float o0 = (v0[0] + b1[0]) * sigmoidf_(v0[1] + b2[0]), o1 = (v0[2] + b1[1]) * sigmoidf_(v0[3] + b2[1]);
                    const float o2 = (v1[0] + b1[2]) * sigmoidf_(v1[1] + b2[2]), o3 = (v1[2] + b1[3]) * sigmoidf_(v1[3] + b2[3]);
                    sq += (o0 * o0 + o1 * o1) + (o2 * o2 + o3 * o3);
                    u32x2 w; w.x = cvtpk(o0, o1); w.y = cvtpk(o2, o3);
                    *(u32x2*)(YCAT + (size_t)row * 2048 + i0) = w;
                }
                sq = quad_sum(sq); if (fq == 0) ss_add(ss + row, sq);
            }
    }
};
struct EpiWo {
    static constexpr bool PERM = true, HOOK = true; static constexpr int T1 = 8, T2 = 24;
    unsigned char* ws; int l; const float* xin;
    const LAS float* FT;
    DI void hook(Acc& acc, int ui, int t, int wr, int fr) const {
        const LAS float* ft = FT + (ui * 2 + (t == T2 ? 1 : 0)) * 256 + wr * 64 + fr;
#pragma unroll
        for (int ai = 0; ai < 2; ++ai)
#pragma unroll
            for (int m = 0; m < 4; ++m) {
                const float f = ft[ai * 128 + m * 16];
#pragma unroll
                for (int bj = 0; bj < 2; ++bj) { acc[ai][bj][m][0] = acc[ai][bj][m][0] * f; acc[ai][bj][m][1] = acc[ai][bj][m][1] * f; }
            }
    }
    DI void operator()(const Acc& acc, const Unit& u, int wr, int wc, int fr, int fq) const {
        const ssacc_t* ss_dil = (const ssacc_t*)(ws + WS_SS) + (size_t)(SS_DIL + l) * M_; ssacc_t* ssx1 = (ssacc_t*)(ws + WS_SS) + (size_t)(SS_X1 + l) * M_;
        float* X = (float*)(ws + WS_X); bf16_t* XB = (bf16_t*)(ws + WS_XB);
#pragma unroll
        for (int ai = 0; ai < 2; ++ai)
#pragma unroll
            for (int m = 0; m < 4; ++m) {
                asm volatile("" ::: "memory");
                const int row = u.pm * 256 + ai * 128 + wr * 64 + m * 16 + fr;
                const float rs = rsqrtf(ss_get(ss_dil + row) * (1.f / 512.f) + EPS_);
                float sq = 0.f;
#pragma unroll
                for (int bj = 0; bj < 2; ++bj) {
                    const size_t off = (size_t)row * 2048 + u.pn * 256 + bj * 128 + wc * 32 + 8 * fq;
                    const f32x4 v0 = *(const f32x4*)(xin + off) + acc[ai][bj][m][0] * rs, v1 = *(const f32x4*)(xin + off + 4) + acc[ai][bj][m][1] * rs;
                    *(f32x4*)(X + off) = v0; *(f32x4*)(X + off + 4) = v1; *(u32x4*)(XB + off) = pack8(v0, v1); sq += sq8(v0, v1);
                }
                sq = quad_sum(sq); if (fq == 0) ss_add(ssx1 + row, sq);
            }
    }
};
struct EpiGateUp {
    static constexpr bool PERM = true, HOOK = false; static constexpr int T1 = -1, T2 = -1;
    const ssacc_t* ssx1; bf16_t* HM;
    DI void hook(Acc&, int, int, int, int) const {}
    DI void operator()(const Acc& acc, const Unit& u, int wr, int wc, int fr, int fq) const {
#pragma unroll
        for (int ai = 0; ai < 2; ++ai)
#pragma unroll
            for (int m = 0; m < 4; ++m) {
                asm volatile("" ::: "memory");
                const int row = u.pm * 256 + ai * 128 + wr * 64 + m * 16 + fr;
                const float rs = rsqrtf(ss_get(ssx1 + row) * (1.f / 2048.f) + EPS_);
#pragma unroll
                for (int bj = 0; bj < 2; ++bj) {
                    const f32x4 v0 = acc[ai][bj][m][0] * rs, v1 = acc[ai][bj][m][1] * rs;
                    const int i0 = (u.pn * 256 + bj * 128 + wc * 32 + 8 * fq) >> 1;
                    const float o0 = v0[0] * sigmoidf_(v0[0]) * v0[1], o1 = v0[2] * sigmoidf_(v0[2]) * v0[3];
                    const float o2 = v1[0] * sigmoidf_(v1[0]) * v1[1], o3 = v1[2] * sigmoidf_(v1[2]) * v1[3];
                    u32x2 w; w.x = cvtpk(o0, o1); w.y = cvtpk(o2, o3);
                    *(u32x2*)(HM + (size_t)row * DFF_ + i0) = w;
                }
            }
    }
};
struct EpiDown {
    static constexpr bool PERM = true, HOOK = false; static constexpr int T1 = -1, T2 = -1;
    float* X; bf16_t* XB; ssacc_t* ssx;
    DI void hook(Acc&, int, int, int, int) const {}
    DI void operator()(const Acc& acc, const Unit& u, int wr, int wc, int fr, int fq) const {
#pragma unroll
        for (int ai = 0; ai < 2; ++ai)
#pragma unroll
            for (int m = 0; m < 4; ++m) {
                asm volatile("" ::: "memory");
                const int row = u.pm * 256 + ai * 128 + wr * 64 + m * 16 + fr;
                float sq = 0.f;
#pragma unroll
                for (int bj = 0; bj < 2; ++bj) {
                    const size_t off = (size_t)row * 2048 + u.pn * 256 + bj * 128 + wc * 32 + 8 * fq;
                    const f32x4 v0 = *(const f32x4*)(X + off) + acc[ai][bj][m][0], v1 = *(const f32x4*)(X + off + 4) + acc[ai][bj][m][1];
                    *(f32x4*)(X + off) = v0; *(f32x4*)(X + off + 4) = v1; *(u32x4*)(XB + off) = pack8(v0, v1); sq += sq8(v0, v1);
                }
                sq = quad_sum(sq); if (fq == 0) ss_add(ssx + row, sq);
            }
    }
};

template <class Epi>
DI void run_gemm(LAS unsigned char* lds, const bf16_t* A, const bf16_t* Bt, int N, int K, const Epi& E) {
    pg8::Gemm g{A, Bt, M_, N, K}; pg8::StaticOrder S; S.init(M_, N, (int)gridDim.x, (int)blockIdx.x);
#if !defined(NO_GEMM)
    pg8::gemm_phase<Epi, pg8::StaticOrder, true, true>(lds, g, S, E);
#endif
    __syncthreads();
}

DI float wave_sum(float v) {
#pragma unroll
    for (int o = 1; o < 64; o <<= 1) v += __shfl_xor(v, o);
    return v;
}
template <int KIND> DI int map_n(int n) {
    if (KIND == 0) {
        if (n < 768) return n;
        if (n < 832) { const int j = n - 768; return 2816 + (j < 32 ? 2 * j : 2 * (j - 32) + 1); }
        return n - 64;
    }
    if (KIND == 1) {
        const int hd = n / 192, w = n % 192;
        if (w < 128) return n;
        const int j = w - 128; return hd * 192 + 128 + (j < 32 ? 2 * j : 2 * (j - 32) + 1);
    }
    if (KIND == 3) return n < 512 ? 2 * n : 2 * (n - 512) + 1;
    if (KIND == 5) return 2 * n;
    if (KIND == 6) return 2 * n + 1;
    return n;
}
template <int KIND>
DI void transpose_item(const float* W, int K, int N, bf16_t* WT, int ldk, const float* g0, const float* g1, const float* g2, LAS float* scr, int item, int lane) {
    const int nblk = N / 32, kb = item / nblk, nb = item % nblk, k0 = 64 * kb, n0 = 32 * nb;
    f32x4 tv[8];
#pragma unroll
    for (int i = 0; i < 8; ++i) tv[i] = *(const f32x4*)(W + (size_t)(k0 + 8 * i + (lane >> 3)) * N + n0 + 4 * (lane & 7));
#pragma unroll
    for (int i = 0; i < 8; ++i) {
        const int kk = 8 * i + (lane >> 3), k = k0 + kk;
        float gn = 1.f;
        if (KIND == 0 || KIND == 1 || KIND == 2 || KIND == 5 || KIND == 6) gn = g0[k];
        if (KIND == 4) gn = k < 1024 ? g0[k] : (k < 1536 ? g1[k - 1024] : g2[k - 1536]);
        LAS float* d = scr + kk * 33 + 4 * (lane & 7);
        d[0] = tv[i][0] * gn; d[1] = tv[i][1] * gn; d[2] = tv[i][2] * gn; d[3] = tv[i][3] * gn;
    }
    asm volatile("s_waitcnt lgkmcnt(0)" ::: "memory");
    int kd0 = k0;
    if (KIND == 4) kd0 = k0 < 1024 ? k0 + 512 : (k0 < 1536 ? k0 - 1024 : k0);
    const int c = lane & 7;
#pragma unroll
    for (int j = 0; j < 4; ++j) { const int n = (lane >> 3) + 8 * j; const LAS float* s = scr + (8 * c) * 33 + n;
        u32x4 o; o.x = cvtpk(s[0 * 33], s[1 * 33]); o.y = cvtpk(s[2 * 33], s[3 * 33]); o.z = cvtpk(s[4 * 33], s[5 * 33]); o.w = cvtpk(s[6 * 33], s[7 * 33]);
        *(u32x4*)(WT + (size_t)map_n<KIND>(n0 + n) * ldk + kd0 + 8 * c) = o; }
    asm volatile("s_waitcnt lgkmcnt(0)" ::: "memory");
}

DI void prologue(PP p, LAS unsigned char* lds) {
    const int tid = opaque_tid(), lane = tid & 63, wid = __builtin_amdgcn_readfirstlane(tid >> 6);
    const int gw = blockIdx.x * 8 + wid, NGW = gridDim.x * 8;
    const int gt = blockIdx.x * 512 + tid, NGT = gridDim.x * 512;
    unsigned char* ws = p->ws;
    { ssacc_t* ss = (ssacc_t*)(ws + WS_SS); for (int i = gt; i < (SS_N - 1) * M_; i += NGT) ss[M_ + i] = 0ull; }
    {
        const float* x = p->in[0]; bf16_t* XB = (bf16_t*)(ws + WS_XB); ssacc_t* ss = (ssacc_t*)(ws + WS_SS);
        for (int m = gw; m < M_; m += NGW) {
            const f32x4* xr = (const f32x4*)(x + (size_t)m * D_) + lane * 2; float s = 0.f;
#pragma unroll
            for (int j = 0; j < 4; ++j) { const f32x4 a = xr[128 * j], b = xr[128 * j + 1]; s += sq8(a, b); *(u32x4*)(XB + (size_t)m * D_ + j * 512 + lane * 8) = pack8(a, b); }
            s = wave_sum(s); if (lane == 0) ss_set(ss + m, s);
        }
    }
    {
        float* rope = (float*)(ws + WS_ROPE);
        for (int i = gt; i < 2048 * 32; i += NGT) {
            const int pos = i >> 5, j = i & 31;
            const double inv = exp(-(double)j * (9.210340371976184 / 32.0));
            double rev = (double)pos * inv * 0.15915494309189535; rev -= rint(rev);
            float sn, cs; sincosf((float)(rev * 6.283185307179586), &sn, &cs);
            rope[2 * i] = cs; rope[2 * i + 1] = sn;
        }
    }
    {
        const float *a_re = p->in[7], *a_im = p->in[8], *b_re = p->in[9], *b_im = p->in[10], *c_re = p->in[11], *c_im = p->in[12], *log_dt = p->in[14];
        float* ABAR = (float*)(ws + WS_ABAR); float* A64 = (float*)(ws + WS_A64); float* BB = (float*)(ws + WS_BB); float* CT = (float*)(ws + WS_CT);
        for (int i = gt; i < 4 * 32 * 64; i += NGT) {
            const int lg = i >> 6;
            const float lre = fminf(a_re[i], -1e-4f), lim = a_im[i];
            const float dt = __expf(log_dt[lg]);
            const double xr = (double)lre * (double)dt, th = (double)lim * (double)dt;
            double rev = th * 0.15915494309189535; rev -= rint(rev);
            const float r = (float)(rev * 6.283185307179586);
            float sn, cs; sincosf(r, &sn, &cs);
            const float ex = __expf((float)xr), em1 = expm1f((float)xr);
            ABAR[2 * i] = ex * cs; ABAR[2 * i + 1] = ex * sn;
            { double rev2 = th * 64.0 * 0.15915494309189535; rev2 -= rint(rev2); float s2, c2; sincosf((float)(rev2 * 6.283185307179586), &s2, &c2);
              const float e2 = __expf((float)(xr * 64.0)); A64[2 * i] = e2 * c2; A64[2 * i + 1] = e2 * s2; }
            float sh, ch; sincosf(0.5f * r, &sh, &ch);
            const float dre = em1 * cs - 2.f * sh * sh, dim = ex * sn;
            const float den = 1.f / (lre * lre + lim * lim);
            const float qre = (dre * lre + dim * lim) * den, qim = (dim * lre - dre * lim) * den;
            for (int pp = 0; pp < 16; ++pp) {
                const float br = b_re[(size_t)i * 16 + pp], bi = b_im[(size_t)i * 16 + pp];
                BB[((size_t)i * 16 + pp) * 2] = qre * br - qim * bi; BB[((size_t)i * 16 + pp) * 2 + 1] = qre * bi + qim * br;
                { bf16_t* BBb = (bf16_t*)(ws + WS_BBB); const int n = i & 63;
                  BBb[((size_t)lg * 128 + 2 * n) * 16 + pp] = (bf16_t)(cvtpk(qre * br - qim * bi, 0.f) & 0xffffu);
                  BBb[((size_t)lg * 128 + 2 * n + 1) * 16 + pp] = (bf16_t)(cvtpk(qre * bi + qim * br, 0.f) & 0xffffu); }
            }
        }
        for (int i = gt; i < 4 * 32 * 4 * 16 * 32; i += NGT) {
            const int kk = i & 31, pp = (i >> 5) & 15, kq = (i >> 9) & 3, lg = i >> 11, k = 32 * kq + kk;
            CT[i] = k < 64 ? c_re[((size_t)lg * 16 + pp) * 64 + k] : -c_im[((size_t)lg * 16 + pp) * 64 + (k - 64)];
        }
        for (int i = gt; i < 4 * 32 * 16 * 128; i += NGT) {
            const int k = i & 127, pp = (i >> 7) & 15, lg = i >> 11, n = k >> 1;
            const float v = (k & 1) ? -c_im[((size_t)lg * 16 + pp) * 64 + n] : c_re[((size_t)lg * 16 + pp) * 64 + n];
            ((bf16_t*)(ws + WS_CTB))[i] = (bf16_t)(cvtpk(v, 0.f) & 0xffffu);
        }
    }
}

DI void convert_weights(PP p, LAS unsigned char* lds, int l, int worker, int nworkers) {
    const int tid = opaque_tid(), lane = tid & 63, wid = __builtin_amdgcn_readfirstlane(tid >> 6);
    unsigned char* ws = p->ws;
    LAS float* scr = (LAS float*)(lds + wid * 16384);
    constexpr int I_IN = 32 * 90, I_UQ = 8 * 48, I_UKV = 4 * 64, I_GLU = 8 * 32, I_O = 32 * 64, I_G = 32 * 176, I_DN = 88 * 64;
    constexpr int I_LAYER = I_IN + I_UQ + I_UKV + I_GLU + I_O + 2 * I_G + I_DN;
    unsigned char* wl = ws + WS_W + (size_t)l * W_LAYER;
    for (int it = worker; it < I_LAYER; it += nworkers) {
        int r = it;
        if (r < I_IN) { transpose_item<0>(p->in[2] + (size_t)l * 2048 * 2880, 2048, 2880, (bf16_t*)(wl + W_IN), 2048, p->in[1] + l * 2048, nullptr, nullptr, scr, r, lane); continue; } r -= I_IN;
        if (r < I_UQ) { transpose_item<1>(p->in[4] + (size_t)l * 512 * 1536, 512, 1536, (bf16_t*)(wl + W_UQ), 512, p->in[3] + l * 512, nullptr, nullptr, scr, r, lane); continue; } r -= I_UQ;
        if (r < I_UKV) { transpose_item<2>(p->in[6] + (size_t)l * 256 * 2048, 256, 2048, (bf16_t*)(wl + W_UKV), 256, p->in[5] + l * 256, nullptr, nullptr, scr, r, lane); continue; } r -= I_UKV;
        if (r < I_GLU) { transpose_item<3>(p->in[15] + (size_t)l * 512 * 1024, 512, 1024, (bf16_t*)(wl + W_GLU), 512, nullptr, nullptr, nullptr, scr, r, lane); continue; } r -= I_GLU;
        if (r < I_O) { transpose_item<4>(p->in[20] + (size_t)l * 2048 * 2048, 2048, 2048, (bf16_t*)(wl + W_O), 2048, p->in[17] + l * 1024, p->in[18] + l * 512, p->in[19] + l * 512, scr, r, lane); continue; } r -= I_O;
        if (r < I_G) { transpose_item<5>(p->in[22] + (size_t)l * 2048 * DFF_, 2048, DFF_, (bf16_t*)(wl + W_GU), 2048, p->in[21] + l * 2048, nullptr, nullptr, scr, r, lane); continue; } r -= I_G;
        if (r < I_G) { transpose_item<6>(p->in[23] + (size_t)l * 2048 * DFF_, 2048, DFF_, (bf16_t*)(wl + W_GU), 2048, p->in[21] + l * 2048, nullptr, nullptr, scr, r, lane); continue; } r -= I_G;
        transpose_item<7>(p->in[24] + (size_t)l * DFF_ * 2048, DFF_, 2048, (bf16_t*)(wl + W_DN), DFF_, nullptr, nullptr, nullptr, scr, r, lane);
    }
}

DI int crow(int i, int h) { return (i & 3) + 8 * (i >> 2) + 4 * h; }
DI bf16x8 pack_step(const f32x16& x, int s) {
    u32x4 w; w.x = cvtpk(x[8 * s], x[8 * s + 1]); w.y = cvtpk(x[8 * s + 2], x[8 * s + 3]); w.z = cvtpk(x[8 * s + 4], x[8 * s + 5]); w.w = cvtpk(x[8 * s + 6], x[8 * s + 7]);
    return __builtin_bit_cast(bf16x8, w);
}
typedef short v4i16_t __attribute__((ext_vector_type(4)));
DI s16x4 vtr(const LAS unsigned char* p) { return __builtin_bit_cast(s16x4, __builtin_amdgcn_ds_read_tr16_b64_v4i16((LAS v4i16_t*)p)); }
#define MFMA32(a, b, c) __builtin_amdgcn_mfma_f32_32x32x16_bf16((a), (b), (c), 0, 0, 0)

struct AttnPtrs {
    unsigned char* ws; int l;
    DI const bf16_t* Q() const { return (const bf16_t*)(ws + WS_Q); }
    DI const bf16_t* KV() const { return (const bf16_t*)(ws + WS_KV); }
    DI const bf16_t* KPE() const { return (const bf16_t*)(ws + WS_KPE); }
    DI const bf16_t* QD() const { return (const bf16_t*)(ws + WS_QD); }
    DI const bf16_t* KD() const { return (const bf16_t*)(ws + WS_KD); }
    DI const bf16_t* VD() const { return (const bf16_t*)(ws + WS_VD); }
    DI bf16_t* YCAT() const { return (bf16_t*)(ws + WS_YCAT); }
    DI ssacc_t* ss_mla() const { return (ssacc_t*)(ws + WS_SS) + (size_t)(SS_MLA + l) * M_; }
    DI bf16_t* DP() const { return (bf16_t*)(ws + WS_DP); }
    DI float* DLSE() const { return (float*)(ws + WS_DLSE); }
};

template <int MODE, bool ATOM = true>
DI void attn_unit(LAS unsigned char* lds, const AttnPtrs& P, int b, int hd, int fi0, int dmul, int r0, int pat, int t_begin, int t_end) {
    constexpr int DQK = MODE == 0 ? 192 : 64, DV = MODE == 0 ? 128 : 64;
    constexpr int KSTR = (DQK + 8) * 2, VSTR = DV * 2 + 32;
    constexpr int CPK = DQK / 8, CPV = DV / 8, NKR = 128 * CPK / 512, NVR = 128 * CPV / 512;
    constexpr int NKK = DQK / 16, NDV = DV / 32;
    constexpr int span = MODE == 0 ? (1 << 30) : 128;
    LAS unsigned char* Ks = lds; LAS unsigned char* Vs = lds + 128 * KSTR;
    const int tid = opaque_tid(), lane = tid & 63, wid = __builtin_amdgcn_readfirstlane(tid >> 6), r = lane & 31, h = lane >> 5, rg = wid & 3, kh = wid >> 2;
    const int fq_ = fi0 + rg * 32 + r;
    const size_t tokq = (size_t)b * 2048 + (size_t)fq_ * dmul + r0;
    constexpr int NQF = MODE == 0 ? 1 : NKK;
    bf16x8 qf[NQF];
    LAS unsigned char* Qs = lds + 128 * KSTR + 128 * VSTR;
    const LAS unsigned char* Qw = Qs + (rg * 32 + r) * KSTR + h * 16;
    if (MODE == 0) {
        const bf16_t* qp = P.Q() + ((size_t)b * 2048 + fi0 + (tid >> 2)) * 1536 + hd * 192 + (tid & 3) * 8;
#pragma unroll
        for (int i = 0; i < 6; ++i) { const u32x4 v = *(const u32x4*)(qp + i * 32); *(LAS u32x4*)(Qs + (tid >> 2) * KSTR + (tid & 3) * 16 + i * 64) = v; }
    } else {
        const bf16_t* qp = P.QD() + tokq * 512 + hd * 64;
#pragma unroll
        for (int kk = 0; kk < NQF; ++kk) qf[kk] = *(const bf16x8*)(qp + kk * 16 + 8 * h);
    }
    f32x16 o[NDV];
#pragma unroll
    for (int d = 0; d < NDV; ++d)
#pragma unroll
        for (int i = 0; i < 16; ++i) o[d][i] = 0.f;
    float mrun = -INFINITY, lrun = 0.f;
    u32x4 kreg[NKR], vreg[NVR];
    const int lkey = tid >> 2, lq = tid & 3;
    const bf16_t* kp0; const bf16_t* kp1;
    if (MODE == 0) { const size_t tok = (size_t)b * 2048 + t_begin * 128 + lkey; kp0 = P.KV() + tok * 2048 + hd * 256 + lq * 8; kp1 = P.KPE() + tok * 64 + lq * 8; }
    else { const size_t tok = (size_t)b * 2048 + (size_t)(t_begin * 128 + lkey) * dmul + r0; kp0 = P.KD() + tok * 512 + hd * 64 + lq * 8; kp1 = P.VD() + tok * 512 + hd * 64 + lq * 8; }
    const size_t kstep0 = MODE == 0 ? (size_t)128 * 2048 : (size_t)128 * dmul * 512, kstep1 = MODE == 0 ? (size_t)128 * 64 : (size_t)128 * dmul * 512;
#define ATT_LOAD() do { \
        if (MODE == 0) { _Pragma("unroll") for (int i_ = 0; i_ < 4; ++i_) { kreg[i_] = *(const u32x4*)(kp0 + i_ * 32); vreg[i_] = *(const u32x4*)(kp0 + 128 + i_ * 32); } \
                         _Pragma("unroll") for (int i_ = 0; i_ < 2; ++i_) kreg[4 + (MODE == 0 ? i_ : 0)] = *(const u32x4*)(kp1 + i_ * 32); } \
        else { _Pragma("unroll") for (int i_ = 0; i_ < 2; ++i_) { kreg[i_] = *(const u32x4*)(kp0 + i_ * 32); vreg[i_] = *(const u32x4*)(kp1 + i_ * 32); } } \
        kp0 += kstep0; kp1 += kstep1; } while (0)
    ATT_LOAD();
    const LAS unsigned char* Kw = Ks + (kh * 64 + r) * KSTR + h * 16;
    const LAS unsigned char* Vw = Vs + (kh * 64 + 4 * h + ((lane & 15) >> 2)) * VSTR + (16 * ((lane >> 4) & 1) + 4 * (lane & 3)) * 2;
    for (int t = t_begin; t < t_end; ++t) {
        __syncthreads();
        {
            LAS unsigned char* kd = Ks + lkey * KSTR + lq * 16; LAS unsigned char* vd = Vs + lkey * VSTR + lq * 16;
            if (MODE == 0) {
#pragma unroll
                for (int i = 0; i < 4; ++i) { *(LAS u32x4*)(kd + i * 64) = kreg[i]; *(LAS u32x4*)(vd + i * 64) = vreg[i]; }
#pragma unroll
                for (int i = 0; i < 2; ++i) *(LAS u32x4*)(kd + 256 + i * 64) = kreg[4 + (MODE == 0 ? i : 0)];
            } else {
#pragma unroll
                for (int i = 0; i < 2; ++i) { *(LAS u32x4*)(kd + i * 64) = kreg[i]; *(LAS u32x4*)(vd + i * 64) = vreg[i]; }
            }
        }
        __syncthreads();
        if (t + 1 < t_end) ATT_LOAD();
        f32x16 x0, x1;
#pragma unroll
        for (int i = 0; i < 16; ++i) { x0[i] = 0.f; x1[i] = 0.f; }
#pragma unroll
        for (int kk = 0; kk < NKK; ++kk) {
            const bf16x8 a0 = *(const LAS bf16x8*)(Kw + kk * 32), a1 = *(const LAS bf16x8*)(Kw + 32 * KSTR + kk * 32);
            const bf16x8 qv = MODE == 0 ? *(const LAS bf16x8*)(Qw + kk * 32) : qf[MODE == 0 ? 0 : kk];
            x0 = MFMA32(a0, qv, x0); x1 = MFMA32(a1, qv, x1);
            if ((kk & 3) == 3) __builtin_amdgcn_sched_barrier(0);
        }
        const int keyb = t * 128 + kh * 64;
        if (MODE == 1 || t == t_end - 1) {
#pragma unroll
            for (int i = 0; i < 16; ++i) {
                const int k0 = keyb + crow(i, h), k1 = k0 + 32;
                if (k0 > fq_ || (MODE == 1 && k0 + span < fq_)) x0[i] = -INFINITY;
                if (k1 > fq_ || (MODE == 1 && k1 + span < fq_)) x1[i] = -INFINITY;
            }
        }
        float mloc = fmaxf(x0[0], x1[0]);
#pragma unroll
        for (int i = 1; i < 16; ++i) mloc = fmaxf(mloc, fmaxf(x0[i], x1[i]));
        mloc = fmaxf(mloc, __shfl_xor(mloc, 32));
        const float mnew = fmaxf(mrun, mloc);
        const float msafe = mnew == -INFINITY ? 0.f : mnew;
        const float alpha = fexp2(mrun - msafe);
        float psum = 0.f;
#pragma unroll
        for (int i = 0; i < 16; ++i) { x0[i] = fexp2(x0[i] - msafe); x1[i] = fexp2(x1[i] - msafe); psum += x0[i] + x1[i]; }
        lrun = lrun * alpha + psum; mrun = mnew;
        if (__builtin_amdgcn_ballot_w64(alpha != 1.f) != 0ull) {
#pragma unroll
            for (int d = 0; d < NDV; ++d)
#pragma unroll
                for (int i = 0; i < 16; ++i) o[d][i] *= alpha;
        }
#pragma unroll
        for (int ht = 0; ht < 2; ++ht)
#pragma unroll
            for (int s = 0; s < 2; ++s) {
                const bf16x8 pf = pack_step(ht == 0 ? x0 : x1, s);
#pragma unroll
                for (int d = 0; d < NDV; ++d) {
                    const s16x4 lo = vtr(Vw + (ht * 32 + 16 * s) * VSTR + d * 64), hi = vtr(Vw + (ht * 32 + 16 * s + 8) * VSTR + d * 64);
                    const bf16x8 pa = __builtin_shufflevector(lo, hi, 0, 1, 2, 3, 4, 5, 6, 7);
                    o[d] = MFMA32(pa, pf, o[d]);
                }
                __builtin_amdgcn_sched_barrier(0);
            }
    }
#undef ATT_LOAD
    lrun += __shfl_xor(lrun, 32);
    __syncthreads();
    LAS float* MS = (LAS float*)lds + rg * ((NDV * 16 + 2) * 64);
    if (kh == 1) {
#pragma unroll
        for (int d = 0; d < NDV; ++d)
#pragma unroll
            for (int i = 0; i < 16; ++i) MS[(d * 16 + i) * 64 + lane] = o[d][i];
        MS[(NDV * 16) * 64 + lane] = mrun; MS[(NDV * 16 + 1) * 64 + lane] = lrun;
    }
    __syncthreads();
    if (kh == 0) {
        const float m1 = MS[(NDV * 16) * 64 + lane], l1 = MS[(NDV * 16 + 1) * 64 + lane];
        const float mm = fmaxf(mrun, m1), ms = mm == -INFINITY ? 0.f : mm;
        const float f0 = fexp2(mrun - ms), f1 = fexp2(m1 - ms);
        const float lt = lrun * f0 + l1 * f1, inv = 1.f / lt;
        float sq = 0.f;
#pragma unroll
        for (int d = 0; d < NDV; ++d)
#pragma unroll
            for (int g = 0; g < 4; ++g) {
                f32x4 v;
#pragma unroll
                for (int e = 0; e < 4; ++e) v[e] = (o[d][4 * g + e] * f0 + MS[(d * 16 + 4 * g + e) * 64 + lane] * f1) * inv;
                const int dv = d * 32 + 8 * g + 4 * h;
                if (MODE == 0) { u32x2 w; w.x = cvtpk(v[0], v[1]); w.y = cvtpk(v[2], v[3]); *(u32x2*)(P.YCAT() + tokq * 2048 + 512 + hd * 128 + dv) = w; sq += (v[0] * v[0] + v[1] * v[1]) + (v[2] * v[2] + v[3] * v[3]); }
                else { u32x2 w; w.x = cvtpk(v[0], v[1]); w.y = cvtpk(v[2], v[3]); *(u32x2*)(P.DP() + ((size_t)pat * M_ + tokq) * 512 + hd * 64 + dv) = w; }
            }
        if (MODE == 0) { sq += __shfl_xor(sq, 32); if (ATOM && h == 0) ss_add(P.ss_mla() + tokq, sq); }
        else { if (h == 0) P.DLSE()[((size_t)pat * M_ + tokq) * 8 + hd] = mm + __log2f(lt); }
    }
}


template <bool ATOM>
DI void mla_unit(LAS unsigned char* lds, const AttnPtrs& P, int b, int hd, int qb) {
    constexpr int KSTR = 400, VSTR = 288, NKK = 12, NDV = 4, BUFB = 64 * KSTR + 64 * VSTR;
    const int tid = opaque_tid(), lane = tid & 63, wid = __builtin_amdgcn_readfirstlane(tid >> 6), r = lane & 31, h = lane >> 5, rg = wid & 3, kh = wid >> 2;
    const int fq_ = qb * 128 + rg * 32 + r;
    const size_t tokq = (size_t)b * 2048 + fq_;
    bf16x8 qf[NKK];
    { const bf16_t* qp = P.Q() + tokq * 1536 + hd * 192;
#pragma unroll
      for (int kk = 0; kk < NKK; ++kk) qf[kk] = *(const bf16x8*)(qp + kk * 16 + 8 * h); }
    f32x16 o[NDV];
#pragma unroll
    for (int d = 0; d < NDV; ++d)
#pragma unroll
        for (int i = 0; i < 16; ++i) o[d][i] = 0.f;
    float mrun = -INFINITY, lrun = 0.f;
    const int lkey = tid >> 3, lq = tid & 7;
    const bf16_t* kp0 = P.KV() + ((size_t)b * 2048 + lkey) * 2048 + hd * 256 + lq * 8;
    const bf16_t* kp1 = P.KPE() + ((size_t)b * 2048 + lkey) * 64 + lq * 8;
    u32x4 sreg[5];
#define MLA_LOAD() do { sreg[0] = *(const u32x4*)(kp0); sreg[1] = *(const u32x4*)(kp0 + 64); sreg[2] = *(const u32x4*)(kp0 + 128); sreg[3] = *(const u32x4*)(kp0 + 192); \
        sreg[4] = *(const u32x4*)(kp1); kp0 += (size_t)64 * 2048; kp1 += (size_t)64 * 64; } while (0)
#define MLA_WRITE(buf) do { LAS unsigned char* kd_ = lds + (buf) * BUFB + lkey * KSTR + lq * 16; LAS unsigned char* vd_ = lds + (buf) * BUFB + 64 * KSTR + lkey * VSTR + lq * 16; \
        *(LAS u32x4*)(kd_) = sreg[0]; *(LAS u32x4*)(kd_ + 128) = sreg[1]; *(LAS u32x4*)(kd_ + 256) = sreg[4]; *(LAS u32x4*)(vd_) = sreg[2]; *(LAS u32x4*)(vd_ + 128) = sreg[3]; } while (0)
    const int nsteps = 2 * (qb + 1);
    __syncthreads();
    MLA_LOAD(); MLA_WRITE(0);
    MLA_LOAD();
    __syncthreads();
    const int kwo = (kh * 32 + r) * KSTR + h * 16;
    const int vwo = 64 * KSTR + (kh * 32 + 4 * h + ((lane & 15) >> 2)) * VSTR + (16 * ((lane >> 4) & 1) + 4 * (lane & 3)) * 2;
    for (int t = 0; t < nsteps; ++t) {
        if (t + 1 < nsteps) MLA_WRITE((t + 1) & 1);
        if (t + 2 < nsteps) MLA_LOAD();
        const int keyb = t * 64 + kh * 32;
        if (keyb <= qb * 128 + rg * 32 + 31) {
            const LAS unsigned char* Kw = lds + (t & 1) * BUFB + kwo;
            const LAS unsigned char* Vw = lds + (t & 1) * BUFB + vwo;
            f32x16 x0;
#pragma unroll
            for (int i = 0; i < 16; ++i) x0[i] = 0.f;
            __builtin_amdgcn_s_setprio(1);
#pragma unroll
            for (int kk = 0; kk < NKK; kk += 2) {
                const bf16x8 a0 = *(const LAS bf16x8*)(Kw + kk * 32), a1 = *(const LAS bf16x8*)(Kw + kk * 32 + 32);
                x0 = MFMA32(a0, qf[kk], x0); x0 = MFMA32(a1, qf[kk + 1], x0);
                if ((kk & 3) == 2) __builtin_amdgcn_sched_barrier(0);
            }
            __builtin_amdgcn_s_setprio(0);
            if (keyb + 31 > qb * 128 + rg * 32) {
#pragma unroll
                for (int i = 0; i < 16; ++i) if (keyb + crow(i, h) > fq_) x0[i] = -INFINITY;
            }
            float mloc = x0[0];
#pragma unroll
            for (int i = 1; i < 16; ++i) mloc = fmaxf(mloc, x0[i]);
            mloc = fmaxf(mloc, __shfl_xor(mloc, 32));
            const float mnew = fmaxf(mrun, mloc);
            const float msafe = mnew == -INFINITY ? 0.f : mnew;
            const float alpha = fexp2(mrun - msafe);
            float psum = 0.f;
#pragma unroll
            for (int i = 0; i < 16; ++i) { x0[i] = fexp2(x0[i] - msafe); psum += x0[i]; }
            lrun = lrun * alpha + psum; mrun = mnew;
            if (__builtin_amdgcn_ballot_w64(alpha != 1.f) != 0ull) {
#pragma unroll
                for (int d = 0; d < NDV; ++d)
#pragma unroll
                    for (int i = 0; i < 16; ++i) o[d][i] *= alpha;
            }
#pragma unroll
            for (int s2 = 0; s2 < 2; ++s2) {
                const bf16x8 pf = pack_step(x0, s2);
#pragma unroll
                for (int d = 0; d < NDV; ++d) {
                    const s16x4 lo = vtr(Vw + (16 * s2) * VSTR + d * 64), hi = vtr(Vw + (16 * s2 + 8) * VSTR + d * 64);
                    const bf16x8 pa = __builtin_shufflevector(lo, hi, 0, 1, 2, 3, 4, 5, 6, 7);
                    o[d] = MFMA32(pa, pf, o[d]);
                }
                __builtin_amdgcn_sched_barrier(0);
            }
        }
        __syncthreads();
    }
#undef MLA_LOAD
#undef MLA_WRITE
    lrun += __shfl_xor(lrun, 32);
    LAS float* MS = (LAS float*)lds + rg * ((NDV * 16 + 2) * 64);
    if (kh == 1) {
#pragma unroll
        for (int d = 0; d < NDV; ++d)
#pragma unroll
            for (int i = 0; i < 16; ++i) MS[(d * 16 + i) * 64 + lane] = o[d][i];
        MS[(NDV * 16) * 64 + lane] = mrun; MS[(NDV * 16 + 1) * 64 + lane] = lrun;
    }
    __syncthreads();
    if (kh == 0) {
        const float m1 = MS[(NDV * 16) * 64 + lane], l1 = MS[(NDV * 16 + 1) * 64 + lane];
        const float mm = fmaxf(mrun, m1), ms = mm == -INFINITY ? 0.f : mm;
        const float f0 = fexp2(mrun - ms), f1 = fexp2(m1 - ms);
        const float lt = lrun * f0 + l1 * f1, inv = 1.f / lt;
        float sq = 0.f;
#pragma unroll
        for (int d = 0; d < NDV; ++d)
#pragma unroll
            for (int g = 0; g < 4; ++g) {
                f32x4 v;
#pragma unroll
                for (int e = 0; e < 4; ++e) v[e] = (o[d][4 * g + e] * f0 + MS[(d * 16 + 4 * g + e) * 64 + lane] * f1) * inv;
                const int dv = d * 32 + 8 * g + 4 * h;
                u32x2 w; w.x = cvtpk(v[0], v[1]); w.y = cvtpk(v[2], v[3]); *(u32x2*)(P.YCAT() + tokq * 2048 + 512 + hd * 128 + dv) = w; sq += (v[0] * v[0] + v[1] * v[1]) + (v[2] * v[2] + v[3] * v[3]);
            }
        sq += __shfl_xor(sq, 32); if (ATOM && h == 0) ss_add(P.ss_mla() + tokq, sq);
    }
}

DI void ssm_s1(PP p, LAS unsigned char* lds, int l) {
    const int tid = opaque_tid(), lane = tid & 63, wid = __builtin_amdgcn_readfirstlane(tid >> 6);
    unsigned char* ws = p->ws;
#define WSF(off) ((float*)(ws + (unsigned)(off)))
#define U WSF(WS_U)
#define ABAR WSF(WS_ABAR)
#define A64 WSF(WS_A64)
#define BB WSF(WS_BB)
#define CT WSF(WS_CT)
#define SST WSF(WS_SST)
    LAS float* US = (LAS float*)(lds + wid * 16384);
    for (int it = blockIdx.x * 8 + wid; it < 4 * 32 * 32; it += gridDim.x * 8) {
        const int g = it & 31, c = (it >> 5) & 31, b = it >> 10, lg = l * 32 + g;
        const size_t tok0 = (size_t)b * 2048 + c * 64;
        { const f32x4* up = (const f32x4*)(U + (tok0 + lane) * 512 + g * 16);
#pragma unroll
          for (int j = 0; j < 4; ++j) *(LAS f32x4*)(US + lane * 16 + 4 * j) = up[j]; }
        const float are = ABAR[(lg * 64 + lane) * 2], aim = ABAR[(lg * 64 + lane) * 2 + 1];
        f32x2 bb[16];
        { const f32x4* bp = (const f32x4*)(BB + ((size_t)(lg * 64 + lane) * 16) * 2);
#pragma unroll
          for (int j = 0; j < 8; ++j) { const f32x4 v = bp[j]; bb[2 * j] = (f32x2){v[0], v[1]}; bb[2 * j + 1] = (f32x2){v[2], v[3]}; } }
        asm volatile("s_waitcnt lgkmcnt(0)" ::: "memory");
        f32x2 hh = {0.f, 0.f}; const f32x2 a1 = {are, are}, a2 = {-aim, aim};
        for (int t = 0; t < 64; ++t) {
            f32x2 uu = {0.f, 0.f};
#pragma unroll
            for (int j = 0; j < 4; ++j) { const f32x4 uv = *(const LAS f32x4*)(US + t * 16 + 4 * j);
#pragma unroll
                for (int e = 0; e < 4; ++e) uu += bb[4 * j + e] * uv[e]; }
            hh = a1 * hh + a2 * (f32x2){hh[1], hh[0]} + uu;
        }
        *(f32x2*)(SST + ((size_t)((b * 32 + c) * 32 + g) * 64 + lane) * 2) = hh;
        asm volatile("s_waitcnt lgkmcnt(0)" ::: "memory");
    }
}
DI void ssm_s3(PP p, LAS unsigned char* lds, int l) {
    const int tid = opaque_tid(), lane = tid & 63, wid = __builtin_amdgcn_readfirstlane(tid >> 6);
    unsigned char* ws = p->ws;
    const float* dskip = p->in[13] + l * 512; bf16_t* YG = (bf16_t*)(ws + (unsigned)WS_YG);
    LAS float* US = (LAS float*)(lds + wid * 16384);
    LAS float* HS = US + 1024;
    for (int it = blockIdx.x * 8 + wid; it < 4 * 32 * 32; it += gridDim.x * 8) {
        const int g = it & 31, c = (it >> 5) & 31, b = it >> 10, lg = l * 32 + g;
        const size_t tok0 = (size_t)b * 2048 + c * 64;
        { const f32x4* up = (const f32x4*)(U + (tok0 + lane) * 512 + g * 16);
#pragma unroll
          for (int j = 0; j < 4; ++j) *(LAS f32x4*)(US + lane * 16 + 4 * j) = up[j]; }
        const float are = ABAR[(lg * 64 + lane) * 2], aim = ABAR[(lg * 64 + lane) * 2 + 1];
        const float a6re = A64[(lg * 64 + lane) * 2], a6im = A64[(lg * 64 + lane) * 2 + 1];
        f32x2 bb[16];
        { const f32x4* bp = (const f32x4*)(BB + ((size_t)(lg * 64 + lane) * 16) * 2);
#pragma unroll
          for (int j = 0; j < 8; ++j) { const f32x4 v = bp[j]; bb[2 * j] = (f32x2){v[0], v[1]}; bb[2 * j + 1] = (f32x2){v[2], v[3]}; } }
        float cc[32];
        { const f32x4* cp = (const f32x4*)(CT + ((size_t)(lg * 4 + (lane >> 4)) * 16 + (lane & 15)) * 32);
#pragma unroll
          for (int j = 0; j < 8; ++j) { const f32x4 v = cp[j]; cc[4 * j] = v[0]; cc[4 * j + 1] = v[1]; cc[4 * j + 2] = v[2]; cc[4 * j + 3] = v[3]; } }
        const float dsk = dskip[g * 16 + (lane & 15)];
        f32x2 hh = {0.f, 0.f}; const f32x2 a1 = {are, are}, a2 = {-aim, aim};
        { const f32x2* sp = (const f32x2*)SST + (size_t)(b * 32 * 32 + g) * 64 + lane;
          const f32x2 c1 = {a6re, a6re}, c2 = {-a6im, a6im};
          f32x2 sv[31];
#pragma unroll
          for (int cp_ = 0; cp_ < 31; ++cp_) sv[cp_] = cp_ < c ? sp[(size_t)cp_ * 32 * 64] : (f32x2){0.f, 0.f};
#pragma unroll
          for (int cp_ = 0; cp_ < 31; ++cp_) if (cp_ < c) hh = c1 * hh + c2 * (f32x2){hh[1], hh[0]} + sv[cp_]; }
        asm volatile("s_waitcnt lgkmcnt(0)" ::: "memory");
        for (int sc = 0; sc < 4; ++sc) {
            for (int t16 = 0; t16 < 16; ++t16) {
                const int t = sc * 16 + t16;
                f32x2 uu = {0.f, 0.f};
#pragma unroll
                for (int j = 0; j < 4; ++j) { const f32x4 uv = *(const LAS f32x4*)(US + t * 16 + 4 * j);
#pragma unroll
                    for (int e = 0; e < 4; ++e) uu += bb[4 * j + e] * uv[e]; }
                hh = a1 * hh + a2 * (f32x2){hh[1], hh[0]} + uu;
                HS[t16 * 132 + lane] = hh[0]; HS[t16 * 132 + 64 + lane] = hh[1];
            }
            asm volatile("s_waitcnt lgkmcnt(0)" ::: "memory");
            f32x4 acc = {0.f, 0.f, 0.f, 0.f};
            const LAS float* hp = HS + (lane & 15) * 132 + 32 * (lane >> 4);
#pragma unroll
            for (int j = 0; j < 8; ++j) { const f32x4 hv = *(const LAS f32x4*)(hp + 4 * j);
#pragma unroll
                for (int e = 0; e < 4; ++e) acc = __builtin_amdgcn_mfma_f32_16x16x4f32(hv[e], cc[4 * j + e], acc, 0, 0, 0); }
#pragma unroll
            for (int j = 0; j < 4; ++j) {
                const int t = sc * 16 + 4 * (lane >> 4) + j;
                float y = acc[j] + dsk * US[t * 16 + (lane & 15)];
                const float z = 0.7978845608028654f * (y + 0.044715f * y * y * y);
                const float th = 1.f - 2.f * __builtin_amdgcn_rcpf(1.f + fexp2(2.f * LOG2E * z));
                y = 0.5f * y * (1.f + th);
                YG[(tok0 + t) * 512 + g * 16 + (lane & 15)] = (bf16_t)(cvtpk(y, 0.f) & 0xffffu);
            }
            asm volatile("s_waitcnt lgkmcnt(0)" ::: "memory");
        }
    }
}

#undef U
#undef ABAR
#undef A64
#undef BB
#undef CT
#undef SST
#undef WSF
#undef U
#undef ABAR
#undef A64
#undef SST
#define MFMA16(a, b, c) __builtin_amdgcn_mfma_f32_16x16x32_bf16((a), (b), (c), 0, 0, 0)
constexpr int SSM_WREG = 16384;
#define WSF(off) ((float*)(ws + (unsigned)(off)))
#define U WSF(WS_U)
#define ABAR WSF(WS_ABAR)
#define A64 WSF(WS_A64)
#define SST WSF(WS_SST)
DI void ssm_load_u(const float* Up, LAS unsigned char* UB, int lane) {
    const f32x4* up = (const f32x4*)Up;
    const f32x4 a = up[0], b = up[1], c = up[2], d = up[3];
    *(LAS u32x4*)(UB + lane * 32) = pack8(a, b); *(LAS u32x4*)(UB + lane * 32 + 16) = pack8(c, d);
    if (lane < 2) *(LAS u32x4*)(UB + 64 * 32 + lane * 16) = (u32x4){0u, 0u, 0u, 0u};
}
DI void ssm_bu16(const LAS unsigned char* UB, LAS float* BUS, const bf16x8 (&bfr)[8], int sc, int lane) {
    const bf16x8 af = *(const LAS bf16x8*)(UB + (lane < 32 ? (sc * 16 + (lane & 15)) * 32 + (lane >> 4) * 16 : 64 * 32));
    f32x4 acc[8];
    asm volatile("s_nop 15" :: "v"(af));
#pragma unroll
    for (int j = 0; j < 8; ++j) acc[j] = MFMA16(af, bfr[j], ((f32x4){0.f, 0.f, 0.f, 0.f}));
    asm volatile("s_nop 15\n\ts_nop 15\n\ts_nop 15\n\ts_nop 15" : "+v"(acc[0]), "+v"(acc[1]), "+v"(acc[2]), "+v"(acc[3]), "+v"(acc[4]), "+v"(acc[5]), "+v"(acc[6]), "+v"(acc[7]) : "v"(af));
#pragma unroll
    for (int j = 0; j < 8; ++j)
#pragma unroll
        for (int e = 0; e < 4; ++e) BUS[(4 * (lane >> 4) + e) * 132 + 16 * j + (lane & 15)] = acc[j][e];
}
DI void ssm_load_bfr(const bf16_t* BBb, int lg, int lane, bf16x8 (&bfr)[8]) {
#pragma unroll
    for (int j = 0; j < 8; ++j) bfr[j] = *(const bf16x8*)(BBb + ((size_t)lg * 128 + 16 * j + (lane & 15)) * 16 + 8 * ((lane >> 4) & 1));
}
DI void ssm_s1_m(PP p, LAS unsigned char* lds, int l) {
    const int tid = opaque_tid(), lane = tid & 63, wid = __builtin_amdgcn_readfirstlane(tid >> 6);
    unsigned char* ws = p->ws;
    LAS unsigned char* UB = lds + wid * SSM_WREG; LAS float* BUS = (LAS float*)(UB + 2176);
    for (int it = blockIdx.x * 8 + wid; it < 4 * 32 * 32; it += gridDim.x * 8) {
        const int g = it & 31, c = (it >> 5) & 31, b = it >> 10, lg = l * 32 + g;
        const size_t tok0 = (size_t)b * 2048 + c * 64;
        ssm_load_u(U + (tok0 + lane) * 512 + g * 16, UB, lane);
        const float are = ABAR[(lg * 64 + lane) * 2], aim = ABAR[(lg * 64 + lane) * 2 + 1];
        bf16x8 bfr[8]; ssm_load_bfr((const bf16_t*)(ws + (unsigned)WS_BBB), lg, lane, bfr);
        asm volatile("s_waitcnt lgkmcnt(0)" ::: "memory");
        f32x2 hh = {0.f, 0.f}; const f32x2 a1 = {are, are}, a2 = {-aim, aim};
        for (int sc = 0; sc < 4; ++sc) {
            ssm_bu16(UB, BUS, bfr, sc, lane);
            asm volatile("s_waitcnt lgkmcnt(0)" ::: "memory");
#pragma unroll 4
            for (int t16 = 0; t16 < 16; ++t16) { const f32x2 bu = *(const LAS f32x2*)(BUS + t16 * 132 + 2 * lane); hh = a1 * hh + a2 * (f32x2){hh[1], hh[0]} + bu; }
            asm volatile("s_waitcnt lgkmcnt(0)" ::: "memory");
        }
        *(f32x2*)(SST + ((size_t)((b * 32 + c) * 32 + g) * 64 + lane) * 2) = hh;
    }
}
DI void ssm_s3_m(PP p, LAS unsigned char* lds, int l) {
    const int tid = opaque_tid(), lane = tid & 63, wid = __builtin_amdgcn_readfirstlane(tid >> 6);
    unsigned char* ws = p->ws;
    const float* dskip = p->in[13] + l * 512; bf16_t* YG = (bf16_t*)(ws + (unsigned)WS_YG);
    LAS unsigned char* UB = lds + wid * SSM_WREG; LAS float* BUS = (LAS float*)(UB + 2176); LAS unsigned char* HB = (LAS unsigned char*)(BUS + 16 * 132);
    for (int it = blockIdx.x * 8 + wid; it < 4 * 32 * 32; it += gridDim.x * 8) {
        const int g = it & 31, c = (it >> 5) & 31, b = it >> 10, lg = l * 32 + g;
        const size_t tok0 = (size_t)b * 2048 + c * 64;
        ssm_load_u(U + (tok0 + lane) * 512 + g * 16, UB, lane);
        const float are = ABAR[(lg * 64 + lane) * 2], aim = ABAR[(lg * 64 + lane) * 2 + 1];
        const float a6re = A64[(lg * 64 + lane) * 2], a6im = A64[(lg * 64 + lane) * 2 + 1];
        bf16x8 bfr[8]; ssm_load_bfr((const bf16_t*)(ws + (unsigned)WS_BBB), lg, lane, bfr);
        bf16x8 cfr[4];
#pragma unroll
        for (int kk = 0; kk < 4; ++kk) cfr[kk] = *(const bf16x8*)((const bf16_t*)(ws + (unsigned)WS_CTB) + ((size_t)lg * 16 + (lane & 15)) * 128 + 32 * kk + 8 * (lane >> 4));
        const float dsk = dskip[g * 16 + (lane & 15)];
        f32x2 hh = {0.f, 0.f}; const f32x2 a1 = {are, are}, a2 = {-aim, aim};
        { const f32x2* sp = (const f32x2*)SST + (size_t)(b * 32 * 32 + g) * 64 + lane;
          const f32x2 c1 = {a6re, a6re}, c2 = {-a6im, a6im};
          f32x2 sv[31];
#pragma unroll
          for (int cp_ = 0; cp_ < 31; ++cp_) sv[cp_] = cp_ < c ? sp[(size_t)cp_ * 32 * 64] : (f32x2){0.f, 0.f};
#pragma unroll
          for (int cp_ = 0; cp_ < 31; ++cp_) if (cp_ < c) hh = c1 * hh + c2 * (f32x2){hh[1], hh[0]} + sv[cp_]; }
        asm volatile("s_waitcnt lgkmcnt(0)" ::: "memory");
        for (int sc = 0; sc < 4; ++sc) {
            ssm_bu16(UB, BUS, bfr, sc, lane);
            asm volatile("s_waitcnt lgkmcnt(0)" ::: "memory");
#pragma unroll 4
            for (int t16 = 0; t16 < 16; ++t16) {
                const f32x2 bu = *(const LAS f32x2*)(BUS + t16 * 132 + 2 * lane);
                hh = a1 * hh + a2 * (f32x2){hh[1], hh[0]} + bu;
                *(LAS unsigned*)(HB + t16 * 272 + 4 * lane) = cvtpk(hh[0], hh[1]);
            }
            asm volatile("s_waitcnt lgkmcnt(0)" ::: "memory");
            f32x4 acc = {0.f, 0.f, 0.f, 0.f};
            bf16x8 hf[4];
#pragma unroll
            for (int kk = 0; kk < 4; ++kk) hf[kk] = *(const LAS bf16x8*)(HB + (lane & 15) * 272 + (32 * kk + 8 * (lane >> 4)) * 2);
            asm volatile("s_waitcnt lgkmcnt(0)\n\ts_nop 15" : "+v"(hf[0]), "+v"(hf[1]), "+v"(hf[2]), "+v"(hf[3]) :: "memory");
#pragma unroll
            for (int kk = 0; kk < 4; ++kk) acc = MFMA16(hf[kk], cfr[kk], acc);
            asm volatile("s_nop 15\n\ts_nop 15\n\ts_nop 15\n\ts_nop 15" : "+v"(acc) : "v"(hf[0]), "v"(hf[1]), "v"(hf[2]), "v"(hf[3]));
#pragma unroll
            for (int j = 0; j < 4; ++j) {
                const int t = sc * 16 + 4 * (lane >> 4) + j;
                float y = acc[j] + dsk * bf2f(*(const LAS bf16_t*)(UB + t * 32 + (lane & 15) * 2));
                const float z = 0.7978845608028654f * (y + 0.044715f * y * y * y);
                const float th = 1.f - 2.f * __builtin_amdgcn_rcpf(1.f + fexp2(2.f * LOG2E * z));
                y = 0.5f * y * (1.f + th);
                YG[(tok0 + t) * 512 + g * 16 + (lane & 15)] = (bf16_t)(cvtpk(y, 0.f) & 0xffffu);
            }
            asm volatile("s_waitcnt lgkmcnt(0)" ::: "memory");
        }
    }
}
#undef MFMA16
#undef WSF
#undef U
#undef ABAR
#undef A64
#undef SST
DI void dil_combine(PP p, int l, int wblk, int nblk) {
    const int tid = opaque_tid(), lane = tid & 63, wid = __builtin_amdgcn_readfirstlane(tid >> 6);
    unsigned char* ws = p->ws;
    const bf16_t* DP = (const bf16_t*)(ws + WS_DP); const float* DLSE = (const float*)(ws + WS_DLSE); bf16_t* YCAT = (bf16_t*)(ws + WS_YCAT);
    ssacc_t* ssd = (ssacc_t*)(ws + WS_SS) + (size_t)(SS_DIL + l) * M_;
    for (int m = wblk * 8 + wid; m < M_; m += nblk * 8) {
        const int hd = lane >> 3;
        const float l0 = DLSE[((size_t)0 * M_ + m) * 8 + hd], l1 = DLSE[((size_t)1 * M_ + m) * 8 + hd], l2 = DLSE[((size_t)2 * M_ + m) * 8 + hd];
        const float mx = fmaxf(l0, fmaxf(l1, l2));
        float w0 = fexp2(l0 - mx), w1 = fexp2(l1 - mx), w2 = fexp2(l2 - mx); const float inv = 1.f / (w0 + w1 + w2); w0 *= inv; w1 *= inv; w2 *= inv;
        const u32x4 q0 = *(const u32x4*)(DP + ((size_t)0 * M_ + m) * 512 + lane * 8), q1 = *(const u32x4*)(DP + ((size_t)1 * M_ + m) * 512 + lane * 8), q2 = *(const u32x4*)(DP + ((size_t)2 * M_ + m) * 512 + lane * 8);
        f32x4 a, bq;
#pragma unroll
        for (int e = 0; e < 4; ++e) {
            const unsigned u0 = q0[e], u1 = q1[e], u2 = q2[e];
            const float lo = __builtin_bit_cast(float, u0 << 16) * w0 + __builtin_bit_cast(float, u1 << 16) * w1 + __builtin_bit_cast(float, u2 << 16) * w2;
            const float hi = __builtin_bit_cast(float, u0 & 0xffff0000u) * w0 + __builtin_bit_cast(float, u1 & 0xffff0000u) * w1 + __builtin_bit_cast(float, u2 & 0xffff0000u) * w2;
            if (e < 2) { a[2 * e] = lo; a[2 * e + 1] = hi; } else { bq[2 * (e - 2)] = lo; bq[2 * (e - 2) + 1] = hi; }
        }
        *(u32x4*)(YCAT + (size_t)m * 2048 + 1536 + lane * 8) = pack8(a, bq);
        const float s = wave_sum(sq8(a, bq)); if (lane == 0) ss_set(ssd + m, s);
    }
}

DI void final_norm(PP p) {
    const int tid = opaque_tid(), lane = tid & 63, wid = __builtin_amdgcn_readfirstlane(tid >> 6);
    const float* X = (const float*)(p->ws + WS_X); const ssacc_t* ss = (const ssacc_t*)(p->ws + WS_SS) + (size_t)(SS_X + 4) * M_; const float* g = p->in[25];
    for (int m = blockIdx.x * 8 + wid; m < M_; m += gridDim.x * 8) {
        const float rs = rsqrtf(ss_get(ss + m) * (1.f / 2048.f) + EPS_);
#pragma unroll
        for (int j = 0; j < 8; ++j) { const int c = j * 256 + lane * 4; const f32x4 v = *(const f32x4*)(X + (size_t)m * 2048 + c), gg = *(const f32x4*)(g + c); *(f32x4*)(p->out + (size_t)m * 2048 + c) = v * rs * gg; }
    }
}


#define XB_TMO      128
#define XB_XCNT(j)  (256  + 64 * (j))
#define XB_XSUB(j)  (1280 + 64 * (j))
#define XB_XGEN(j)  (2304 + 64 * (j))
#define XB_TOP      3328
#define XB_TOPGEN   3392
#define XCD_BAR_WORDS 3456
#define XB_SPIN_CAP (1u << 22)
DI unsigned xb_ld(unsigned* p)              { return __hip_atomic_load(p, __ATOMIC_RELAXED, __HIP_MEMORY_SCOPE_AGENT); }
DI unsigned xb_add(unsigned* p, unsigned v) { return __hip_atomic_fetch_add(p, v, __ATOMIC_RELAXED, __HIP_MEMORY_SCOPE_AGENT); }
DI unsigned xb_xcc_id() { return (unsigned)__builtin_amdgcn_s_getreg((3 << 11) | 20) & 0xFu; }
#define XB_SPIN(cond, bar) do { unsigned _sp = 0; while (cond) { __builtin_amdgcn_s_sleep(1); \
    if ((++_sp & 255u) == 0u) { if (xb_ld(&(bar)[XB_TMO])) break; if (_sp > XB_SPIN_CAP) { atomicAdd(&(bar)[XB_TMO], 1u); break; } } } } while (0)
struct XcdBarrier { unsigned* bar; unsigned x; volatile LAS unsigned* st; };
DI XcdBarrier xcd_barrier_post(unsigned* bar, volatile LAS unsigned* st) {
    XcdBarrier b; b.bar = bar; b.x = xb_xcc_id(); b.st = st;
    if (threadIdx.x == 0) (void)xb_add(&bar[XB_XCNT(b.x)], 1u);
    return b;
}
DI void xcd_barrier_complete(unsigned* bar, unsigned x, unsigned& nloc, unsigned& nx) {
    const unsigned G = gridDim.x * gridDim.y * gridDim.z;
    unsigned sum, cnt, mine, sp = 0u;
    for (;;) {
        sum = 0u; cnt = 0u; mine = 0u;
#pragma unroll
        for (unsigned j = 0; j < 16; ++j) { const unsigned c = xb_ld(&bar[XB_XCNT(j)]); sum += c; cnt += (c > 0u) ? 1u : 0u; mine = (j == x) ? c : mine; }
        if (sum == G) break;
        __builtin_amdgcn_s_sleep(1);
        if ((++sp & 255u) == 0u) { if (xb_ld(&bar[XB_TMO])) break; if (sp > XB_SPIN_CAP) { atomicAdd(&bar[XB_TMO], 1u); break; } }
    }
    nloc = mine > 0u ? mine : 1u; nx = cnt > 0u ? cnt : 1u;
}
DI void xcd_barrier(const XcdBarrier& b) {
    asm volatile("s_waitcnt vmcnt(0)" ::: "memory");
    __syncthreads();
    if (threadIdx.x == 0) {
        unsigned* bar = b.bar;
        __builtin_amdgcn_s_waitcnt(0);
        unsigned nloc = b.st[0], nx = b.st[1];
        if (nloc == 0u) { xcd_barrier_complete(bar, b.x, nloc, nx); b.st[0] = nloc; b.st[1] = nx; }
        const unsigned old = xb_add(&bar[XB_XSUB(b.x)], 1u);
        const unsigned gen = old / nloc;
        if (old + 1u == (gen + 1u) * nloc) {
            __builtin_amdgcn_fence(__ATOMIC_RELEASE, "agent");
            asm volatile("s_waitcnt vmcnt(0)" ::: "memory");
            const unsigned og = xb_add(&bar[XB_TOP], 1u);
            const unsigned tg = og / nx;
            if (og + 1u == (tg + 1u) * nx) xb_add(&bar[XB_TOPGEN], 1u);
            else XB_SPIN(xb_ld(&bar[XB_TOPGEN]) == tg, bar);
            __builtin_amdgcn_fence(__ATOMIC_ACQUIRE, "agent");
            xb_add(&bar[XB_XGEN(b.x)], 1u);
            asm volatile("s_waitcnt vmcnt(0)" ::: "memory");
        } else {
            XB_SPIN(xb_ld(&bar[XB_XGEN(b.x)]) == gen, bar);
            __builtin_amdgcn_fence(__ATOMIC_ACQUIRE, "agent");
            asm volatile("s_waitcnt vmcnt(0)" ::: "memory");
        }
    }
    __syncthreads();
}
__global__ void __launch_bounds__(512, 2) hymba_fwd(Params p_unused) {
    extern __shared__ __attribute__((aligned(16))) unsigned char lds_raw[];
    LAS unsigned char* lds = (LAS unsigned char*)lds_raw;
    cg::grid_group grid = cg::this_grid();
#define SSP(ws, idx, l) ((ssacc_t*)((ws) + WS_SS) + (size_t)((idx) + (l)) * M_)
    volatile LAS unsigned* bst = (volatile LAS unsigned*)(lds + LDS_BYTES - 256);
    if (threadIdx.x < 2) bst[threadIdx.x] = 0u;
    __syncthreads();
    XcdBarrier xbar = xcd_barrier_post((unsigned*)(getpp()->ws + WS_CTL), bst);
#define GRID_SYNC() xcd_barrier(xbar)
#define TAIL_CONVERT(NWG, HALF) do { if (l + 1 < DEPTH_) { const int G_ = (int)gridDim.x, rem_ = (NWG) % G_; const int first_ = rem_ == 0 ? 0 : rem_, nb_ = G_ - first_; \
        if ((int)blockIdx.x >= first_) convert_weights(getpp(), lds, l + 1, (((int)blockIdx.x - first_) * 8 + (int)(threadIdx.x >> 6)) * 2 + (HALF), nb_ * 8 * 2); } } while (0)
#if !defined(NO_PRO)
    prologue(getpp(), lds);
    convert_weights(getpp(), lds, 0, blockIdx.x * 8 + (threadIdx.x >> 6), gridDim.x * 8);
#endif
    grid.sync();

    for (int l = 0; l < DEPTH_; ++l) {
#if GEMM_MASK & 1
        { PP p = getpp(); unsigned char* ws = p->ws; const unsigned char* wl = ws + WS_W + (size_t)l * W_LAYER;
          EpiInProj E{ws, l};
          run_gemm(lds, (const bf16_t*)(ws + WS_XB), (const bf16_t*)(wl + W_IN), NIN_, 2048, E); }
#endif
        TAIL_CONVERT(384, 0);
        GRID_SYNC();
#if GEMM_MASK & 2
        { PP p = getpp(); unsigned char* ws = p->ws; const unsigned char* wl = ws + WS_W + (size_t)l * W_LAYER;
          EpiQUp E{SSP(ws, SS_Q, l), (const float*)(ws + WS_ROPE), (bf16_t*)(ws + WS_Q)}; for (int rep = 0; rep < ((DUP_GEMM & 1) ? 2 : 1); ++rep) run_gemm(lds, (const bf16_t*)(ws + WS_CQ), (const bf16_t*)(wl + W_UQ), 1536, 512, E); }
#endif
#if GEMM_MASK & 4
        { PP p = getpp(); unsigned char* ws = p->ws; const unsigned char* wl = ws + WS_W + (size_t)l * W_LAYER;
          EpiKvUp E{SSP(ws, SS_KV, l), (bf16_t*)(ws + WS_KV)}; for (int rep = 0; rep < ((DUP_GEMM & 1) ? 2 : 1); ++rep) run_gemm(lds, (const bf16_t*)(ws + WS_CKV), (const bf16_t*)(wl + W_UKV), 2048, 256, E); }
#endif
        { PP p = getpp(); unsigned char* ws = p->ws;
          AttnPtrs AP{ws, l};
          for (int it = blockIdx.x; it < 1536; it += gridDim.x) {
              const int pat = it >> 9, b = (it >> 7) & 3, hd = (it >> 4) & 7, x = it & 15;
              const int dmul = pat == 0 ? 1 : (pat == 1 ? 4 : 16), nper = 16 / dmul, r0 = x / nper, nbk = x % nper;
#if !defined(NO_ATT1)
              attn_unit<1>(lds, AP, b, hd, nbk * 128, dmul, r0, pat, nbk > 0 ? nbk - 1 : 0, nbk + 1);
              if (DUP_MIX & 1) attn_unit<1>(lds, AP, b, hd, nbk * 128, dmul, r0, pat, nbk > 0 ? nbk - 1 : 0, nbk + 1);
#endif
          }
          __syncthreads(); }
#if !defined(NO_SSM)
        ssm_s1_m(getpp(), lds, l);
        if (DUP_MIX & 2) ssm_s1(getpp(), lds, l);
#endif
        GRID_SYNC();
#if !defined(NO_SSM)
        ssm_s3_m(getpp(), lds, l);
        if (DUP_MIX & 8) ssm_s3(getpp(), lds, l);
#endif
        __syncthreads();
        { PP p = getpp(); unsigned char* ws = p->ws;
          AttnPtrs AP{ws, l};
          LAS int* tk = (LAS int*)(lds + LDS_BYTES - 128);
          if (threadIdx.x == 0) {
              unsigned* ctl = (unsigned*)(ws + WS_CTL); int pr0 = -1;
              if (gridDim.x == 256) { bool uni = true;
                  for (int jx = 0; jx < 16; ++jx) uni = uni && (xb_ld(&ctl[XB_XCNT(jx)]) == (jx < 8 ? 32u : 0u));
                  if (uni) { const unsigned xcc = xb_xcc_id(); const unsigned tkt = xb_add(&ctl[8192 + l * 16 + xcc], 1u); if (xcc < 8 && tkt < 32) pr0 = (int)((xcc * 4 + (tkt >> 3)) * 8 + (tkt & 7)); } }
              *tk = pr0;
          }
          __syncthreads();
          const int prx = *tk;
          for (int pr = blockIdx.x; pr < 256; pr += gridDim.x) {
              const int pq = prx >= 0 ? prx : pr;
              const int bh = pq >> 3, j = pq & 7, b = bh >> 3, hd = bh & 7;
#if !defined(NO_ATT0)
              mla_unit<true>(lds, AP, b, hd, j);
              mla_unit<true>(lds, AP, b, hd, 15 - j);
              if (DUP_MIX & 16) { mla_unit<false>(lds, AP, b, hd, j); mla_unit<false>(lds, AP, b, hd, 15 - j); }
#endif
          }
          __syncthreads(); }
        GRID_SYNC();
#if GEMM_MASK & 8
        { PP p = getpp(); unsigned char* ws = p->ws; const unsigned char* wl = ws + WS_W + (size_t)l * W_LAYER;
          EpiGlu E{p->in[16] + l * 1024, (bf16_t*)(ws + WS_YCAT), SSP(ws, SS_SSM, l)}; run_gemm(lds, (const bf16_t*)(ws + WS_YG), (const bf16_t*)(wl + W_GLU), 1024, 512, E); }
#endif
        { const int G_ = (int)gridDim.x, first_ = G_ > 128 ? 128 : 0; if ((int)blockIdx.x >= first_) dil_combine(getpp(), l, (int)blockIdx.x - first_, G_ - first_); }
        GRID_SYNC();
#if GEMM_MASK & 16
        { PP p = getpp(); unsigned char* ws = p->ws; const unsigned char* wl = ws + WS_W + (size_t)l * W_LAYER;
          const ssacc_t *ss_ssm = SSP(ws, SS_SSM, l), *ss_mla = SSP(ws, SS_MLA, l), *ss_dil = SSP(ws, SS_DIL, l);
          LAS float* FT = (LAS float*)(lds + 131072);
          { pg8::StaticOrder S; S.init(M_, 2048, (int)gridDim.x, (int)blockIdx.x);
            const int ui = threadIdx.x >> 8, rr = threadIdx.x & 255; Unit u;
            if (S.next(ui, u)) { const int row = u.pm * 256 + rr; const float rm = rsqrtf(ss_get(ss_mla + row) * (1.f / 1024.f) + EPS_), rsm = rsqrtf(ss_get(ss_ssm + row) * (1.f / 512.f) + EPS_), rd = rsqrtf(ss_get(ss_dil + row) * (1.f / 512.f) + EPS_);
                FT[(ui * 2 + 0) * 256 + rr] = rsm / rm; FT[(ui * 2 + 1) * 256 + rr] = rm / rd; }
            __syncthreads(); }
          float* X = (float*)(ws + WS_X);
          EpiWo E{ws, l, l == 0 ? p->in[0] : X, FT}; run_gemm(lds, (const bf16_t*)(ws + WS_YCAT), (const bf16_t*)(wl + W_O), 2048, 2048, E); }
#endif
        GRID_SYNC();
#if GEMM_MASK & 32
        { PP p = getpp(); unsigned char* ws = p->ws; const unsigned char* wl = ws + WS_W + (size_t)l * W_LAYER;
          EpiGateUp E{SSP(ws, SS_X1, l), (bf16_t*)(ws + WS_HM)}; for (int rep = 0; rep < ((DUP_GEMM & 2) ? 2 : 1); ++rep) run_gemm(lds, (const bf16_t*)(ws + WS_XB), (const bf16_t*)(wl + W_GU), 2 * DFF_, 2048, E); }
#endif
        TAIL_CONVERT(1408, 1);
        GRID_SYNC();
#if GEMM_MASK & 64
        { PP p = getpp(); unsigned char* ws = p->ws; const unsigned char* wl = ws + WS_W + (size_t)l * W_LAYER;
          EpiDown E{(float*)(ws + WS_X), (bf16_t*)(ws + WS_XB), SSP(ws, SS_X, l + 1)}; run_gemm(lds, (const bf16_t*)(ws + WS_HM), (const bf16_t*)(wl + W_DN), 2048, DFF_, E); }
#endif
        GRID_SYNC();
    }
    final_norm(getpp());
}

extern "C" void kernel_launch(void* const* d_in, const int* in_sizes, int n_in, void* d_out, int out_size, void* d_ws, size_t ws_size, hipStream_t stream) {
    static int grid = 0;
    if (grid == 0) {
        if (n_in != 26 || out_size != M_ * D_ || ws_size < WS_END) { fprintf(stderr, "kernel_launch: unexpected shapes: n_in %d out %d ws %zu (need %zu)\n", n_in, out_size, ws_size, (size_t)WS_END); grid = -1; return; }
        int dev = 0, cus = 0, per_cu = 0;
        hipGetDevice(&dev); hipDeviceGetAttribute(&cus, hipDeviceAttributeMultiprocessorCount, dev);
        if (hipFuncSetAttribute((const void*)hymba_fwd, hipFuncAttributeMaxDynamicSharedMemorySize, LDS_BYTES) != hipSuccess) { fprintf(stderr, "kernel_launch: hipFuncSetAttribute failed\n"); grid = -1; return; }
        if (hipOccupancyMaxActiveBlocksPerMultiprocessor(&per_cu, (const void*)hymba_fwd, 512, LDS_BYTES) != hipSuccess || per_cu < 1) { fprintf(stderr, "kernel_launch: occupancy query gave %d\n", per_cu); per_cu = 1; }
        (void)hipGetLastError();
        grid = cus * 1;
        fprintf(stderr, "kernel_launch: grid %d (per_cu %d)\n", grid, per_cu);
    }
    if (grid < 0) return;
    if (hipMemsetAsync((char*)d_ws + WS_CTL, 0, 65536, stream) != hipSuccess) { fprintf(stderr, "kernel_launch: memset failed\n"); return; }
    Params p{};
    for (int i = 0; i < 26; ++i) p.in[i] = (const float*)d_in[i];
    p.out = (float*)d_out; p.ws = (unsigned char*)d_ws;
    void* args[] = {&p};
    hipError_t e = hipLaunchCooperativeKernel((const void*)hymba_fwd, dim3(grid), dim3(512), args, LDS_BYTES, stream);
    if (e != hipSuccess) fprintf(stderr, "cooperative launch failed: %s (grid %d)\n", hipGetErrorString(e), grid);
}
```
